# Optimizing an MI355X kernel written in HIP

```python
import math
import jax, jax.numpy as jnp
from jax import lax
import numpy as np

D_MODEL = 1024
BATCH = 4
SEQ = 8192
DEPTH = 4

N_MIXERS = 2
N_ATTN_LAYERS = (DEPTH + 1) // 2
N_MLSTM_LAYERS = DEPTH // 2

ATTN_HEADS = 16
ATTN_HEAD_DIM = D_MODEL // ATTN_HEADS
DILATION_PATTERNS = ((128, 1), (512, 4), (2048, 16))
N_GROUPS = len(DILATION_PATTERNS)
ATTN_GROUP_WIDTH = ATTN_HEADS * ATTN_HEAD_DIM
ATTN_IN_WIDTH = 3 * N_GROUPS * ATTN_GROUP_WIDTH
REL_BUCKETS = 32
REL_MAX_DISTANCE = 2048

MLSTM_HEADS = 4
MLSTM_V_DIM = D_MODEL // MLSTM_HEADS
MLSTM_QK_DIM = MLSTM_V_DIM // 2
MLSTM_CHUNK = 64
CONV_WIDTH = 4
MLSTM_QK_WIDTH = 2 * MLSTM_HEADS * MLSTM_QK_DIM
MLSTM_VW = MLSTM_HEADS * MLSTM_V_DIM
MLSTM_IN_WIDTH = MLSTM_QK_WIDTH + MLSTM_VW + D_MODEL + 2 * MLSTM_HEADS

D_FF = 4 * D_MODEL
EPS = 1e-6

kernel_name = "hybrid_dilated_attn_mlstm_trunk"


def rms_norm(x, g):
    xf = x.astype(jnp.float32)
    y = xf * lax.rsqrt(jnp.mean(xf * xf, axis=-1, keepdims=True) + EPS)
    return (y * g.astype(jnp.float32)).astype(x.dtype)


def t5_bucket(dist):
    max_exact = REL_BUCKETS // 2
    d = jnp.maximum(dist.astype(jnp.float32), 1.0)
    large = max_exact + (jnp.log(d / max_exact) / math.log(REL_MAX_DISTANCE / max_exact)
                         * (REL_BUCKETS - max_exact)).astype(jnp.int32)
    large = jnp.minimum(large, REL_BUCKETS - 1)
    return jnp.where(dist < max_exact, dist, large)


def dilated_window_attention(q, k, v, rel_bias, window, dilation):
    b, s, h, e = q.shape
    band = window // dilation
    span = band * dilation
    s_pad = -(-s // span) * span
    n_blk = s_pad // span

    def to_blocks(t):
        t = jnp.pad(t, ((0, 0), (0, s_pad - s), (0, 0), (0, 0)))
        return t.reshape(b, n_blk, band, dilation, h, e)

    def with_prev(t):
        prev = jnp.pad(t[:, :-1], ((0, 0), (1, 0), (0, 0), (0, 0), (0, 0), (0, 0)))
        return jnp.concatenate([prev, t], axis=2)

    qb = to_blocks(q)
    kk = with_prev(to_blocks(k))
    vv = with_prev(to_blocks(v))

    scores = jnp.einsum('bnqrhe,bnkrhe->bnrhqk', qb, kk)
    qi = jnp.arange(band)[:, None]
    ki = jnp.arange(2 * band)[None, :]
    steps = qi - ki + band
    valid = (steps >= 0) & (steps <= band)
    blk_valid = valid[None] & ((jnp.arange(n_blk)[:, None, None] > 0) | (ki >= band)[None])
    bias = jnp.transpose(rel_bias[t5_bucket(jnp.clip(steps, 0, band) * dilation)], (2, 0, 1))
    scores = scores + bias.astype(jnp.float32)[None, None, None]
    scores = jnp.where(blk_valid[None, :, None, None], scores, -jnp.inf)

    m = jnp.max(scores, axis=-1, keepdims=True)
    ex = jnp.exp(scores - m)
    den = jnp.sum(ex, axis=-1, keepdims=True)
    out = jnp.einsum('bnrhqk,bnkrhe->bnqrhe', ex / den, vv)
    lse = (m + jnp.log(den))[..., 0]
    out = out.reshape(b, s_pad, h, e)[:, :s]
    lse = jnp.transpose(lse, (0, 1, 4, 2, 3)).reshape(b, s_pad, h)[:, :s]
    return out, lse


def attention_mixer(x, w_in, q_gain, k_gain, w_out, rel_bias):
    b, s, _ = x.shape
    qkv = (x @ w_in).astype(jnp.float32).reshape(b, s, 3, N_GROUPS, ATTN_HEADS, ATTN_HEAD_DIM)
    outs, lses = [], []
    for g, (window, dilation) in enumerate(DILATION_PATTERNS):
        q = rms_norm(qkv[:, :, 0, g], q_gain[g]) * (ATTN_HEAD_DIM ** -0.5)
        k = rms_norm(qkv[:, :, 1, g], k_gain[g])
        o, l = dilated_window_attention(q, k, qkv[:, :, 2, g], rel_bias[:, g], window, dilation)
        outs.append(o)
        lses.append(l)
    wts = jax.nn.softmax(jnp.stack(lses), axis=0)
    y = jnp.einsum('gbsh,gbshe->bshe', wts, jnp.stack(outs))
    return y.reshape(b, s, ATTN_GROUP_WIDTH).astype(x.dtype) @ w_out


def causal_depthwise_conv(x, w, bias):
    y = lax.conv_general_dilated(x, w[:, None, :].astype(x.dtype), window_strides=(1,),
                                 padding=[(CONV_WIDTH - 1, 0)],
                                 dimension_numbers=('NWC', 'WIO', 'NWC'),
                                 feature_group_count=x.shape[-1])
    return y + bias.astype(x.dtype)


def mlstm_chunkwise(q, k, v, log_i, log_f):
    b, h, s, dk = q.shape
    dv = v.shape[-1]
    L = MLSTM_CHUNK
    nc = s // L

    def chunks(t):
        return jnp.moveaxis(t.reshape(b, h, nc, L, *t.shape[3:]), 2, 0)

    causal = jnp.tril(jnp.ones((L, L), dtype=bool))

    def step(carry, xs):
        c_prev, n_prev, m_prev = carry
        qc, kc, vc, ic, fc = xs
        bcum = jnp.cumsum(fc, axis=-1)
        d = jnp.where(causal, bcum[..., :, None] - bcum[..., None, :] + ic[..., None, :], -jnp.inf)
        m_t = jnp.maximum(bcum + m_prev[..., None], jnp.max(d, axis=-1))
        inter = jnp.exp(bcum + m_prev[..., None] - m_t)
        wts = jnp.einsum('bhtd,bhsd->bhts', qc, kc) * jnp.exp(d - m_t[..., None])
        num = inter[..., None] * jnp.einsum('bhvd,bhtd->bhtv', c_prev, qc) + jnp.einsum('bhts,bhsv->bhtv', wts, vc)
        den = inter * jnp.einsum('bhd,bhtd->bht', n_prev, qc) + jnp.sum(wts, axis=-1)
        hc = num / jnp.maximum(jnp.abs(den), jnp.exp(-m_t))[..., None]
        b_last = bcum[..., -1]
        a = b_last[..., None] - bcum + ic
        m_new = jnp.maximum(b_last + m_prev, jnp.max(a, axis=-1))
        decay = jnp.exp(b_last + m_prev - m_new)
        wk = jnp.exp(a - m_new[..., None])
        c_new = decay[..., None, None] * c_prev + jnp.einsum('bhs,bhsv,bhsd->bhvd', wk, vc, kc)
        n_new = decay[..., None] * n_prev + jnp.einsum('bhs,bhsd->bhd', wk, kc)
        return (c_new, n_new, m_new), hc

    init = (jnp.zeros((b, h, dv, dk), jnp.float32), jnp.zeros((b, h, dk), jnp.float32),
            jnp.zeros((b, h), jnp.float32))
    _, hs = lax.scan(step, init, (chunks(q), chunks(k), chunks(v), chunks(log_i), chunks(log_f)))
    return jnp.moveaxis(hs, 0, 2).reshape(b, h, s, dv)


def mlstm_mixer(x, w_in, gate_bias, conv_w, conv_b, out_gain, w_out):
    b, s, _ = x.shape
    hh = MLSTM_HEADS
    proj = x @ w_in
    qk, v, o_pre, gates = jnp.split(proj, [MLSTM_QK_WIDTH, MLSTM_QK_WIDTH + MLSTM_VW,
                                           MLSTM_QK_WIDTH + MLSTM_VW + D_MODEL], axis=-1)
    qk = jax.nn.silu(causal_depthwise_conv(qk, conv_w, conv_b))
    q, k = jnp.split(qk, 2, axis=-1)
    gates = gates.astype(jnp.float32) + gate_bias.astype(jnp.float32)
    log_i = jnp.transpose(gates[..., :hh], (0, 2, 1))
    log_f = jnp.transpose(jax.nn.log_sigmoid(gates[..., hh:]), (0, 2, 1))

    def heads(t, dh):
        return jnp.transpose(t.astype(jnp.float32).reshape(b, s, hh, dh), (0, 2, 1, 3))

    hcell = mlstm_chunkwise(heads(q, MLSTM_QK_DIM) * (MLSTM_QK_DIM ** -0.5), heads(k, MLSTM_QK_DIM),
                            heads(v, MLSTM_V_DIM), log_i, log_f)
    hcell = rms_norm(jnp.transpose(hcell, (0, 2, 1, 3)), out_gain)
    y = hcell.reshape(b, s, MLSTM_VW) * jax.nn.sigmoid(o_pre.astype(jnp.float32))
    return y.astype(x.dtype) @ w_out


def sq_relu_mlp(x, w1, w2):
    hid = jax.nn.relu(x @ w1)
    return (hid * hid) @ w2


def setup_inputs(seed: int = 0) -> dict:
    key = jax.random.key(seed)
    ks = jax.random.split(key, 20)
    f32 = jnp.float32
    res_scale = (2.0 * DEPTH) ** -0.5
    nrm = lambda k, shape, sc: jax.random.normal(k, shape, f32) * sc
    f_bias = jnp.linspace(3.0, 6.0, MLSTM_HEADS, dtype=f32)
    gate_bias = jnp.concatenate([
        nrm(ks[9], (N_MLSTM_LAYERS, MLSTM_HEADS), 0.1),
        f_bias[None] + nrm(ks[10], (N_MLSTM_LAYERS, MLSTM_HEADS), 0.1)], axis=-1)
    return {
        "x": nrm(ks[0], (BATCH, SEQ, D_MODEL), 1.0),
        "mixer_norm": 1.0 + nrm(ks[1], (DEPTH, D_MODEL), 0.02),
        "mlp_norm": 1.0 + nrm(ks[2], (DEPTH, D_MODEL), 0.02),
        "rel_bias": nrm(ks[3], (REL_BUCKETS, N_GROUPS, ATTN_HEADS), 0.5),
        "attn_w_in": nrm(ks[4], (N_ATTN_LAYERS, D_MODEL, ATTN_IN_WIDTH), D_MODEL ** -0.5),
        "attn_q_gain": 1.0 + nrm(ks[5], (N_ATTN_LAYERS, N_GROUPS, ATTN_HEAD_DIM), 0.02),
        "attn_k_gain": 1.0 + nrm(ks[6], (N_ATTN_LAYERS, N_GROUPS, ATTN_HEAD_DIM), 0.02),
        "attn_w_out": nrm(ks[7], (N_ATTN_LAYERS, ATTN_GROUP_WIDTH, D_MODEL), ATTN_GROUP_WIDTH ** -0.5 * res_scale),
        "mlstm_w_in": nrm(ks[8], (N_MLSTM_LAYERS, D_MODEL, MLSTM_IN_WIDTH), D_MODEL ** -0.5),
        "mlstm_gate_bias": gate_bias,
        "mlstm_conv_w": nrm(ks[11], (N_MLSTM_LAYERS, CONV_WIDTH, MLSTM_QK_WIDTH), CONV_WIDTH ** -0.5),
        "mlstm_conv_b": nrm(ks[12], (N_MLSTM_LAYERS, MLSTM_QK_WIDTH), 0.02),
        "mlstm_out_gain": 1.0 + nrm(ks[13], (N_MLSTM_LAYERS, MLSTM_HEADS, MLSTM_V_DIM), 0.02),
        "mlstm_w_out": nrm(ks[14], (N_MLSTM_LAYERS, MLSTM_VW, D_MODEL), MLSTM_VW ** -0.5 * res_scale),
        "mlp_w_in": nrm(ks[15], (DEPTH, D_MODEL, D_FF), D_MODEL ** -0.5),
        "mlp_w_out": nrm(ks[16], (DEPTH, D_FF, D_MODEL), D_FF ** -0.5 * res_scale),
    }


def reference(x, mixer_norm, mlp_norm, rel_bias, attn_w_in, attn_q_gain, attn_k_gain, attn_w_out,
              mlstm_w_in, mlstm_gate_bias, mlstm_conv_w, mlstm_conv_b, mlstm_out_gain, mlstm_w_out,
              mlp_w_in, mlp_w_out):
    for layer in range(DEPTH):
        j = layer // N_MIXERS
        hnorm = rms_norm(x, mixer_norm[layer])
        if layer % N_MIXERS == 0:
            x = x + attention_mixer(hnorm, attn_w_in[j], attn_q_gain[j], attn_k_gain[j],
                                    attn_w_out[j], rel_bias)
        else:
            x = x + mlstm_mixer(hnorm, mlstm_w_in[j], mlstm_gate_bias[j], mlstm_conv_w[j],
                                mlstm_conv_b[j], mlstm_out_gain[j], mlstm_w_out[j])
        x = x + sq_relu_mlp(rms_norm(x, mlp_norm[layer]), mlp_w_in[layer], mlp_w_out[layer])
    return x
```

```cpp
#include <hip/hip_runtime.h>
#include <cstdio>
#include <cstdint>
#include <cmath>
__device__ __forceinline__ int opaque_tid() { int t = threadIdx.x; asm volatile("" : "+v"(t)); return t; }
namespace pg8 {
#define PG8_LAS __attribute__((address_space(3)))
typedef unsigned short bf16_t;
typedef short bf16x8 __attribute__((ext_vector_type(8)));
typedef float f32x4 __attribute__((ext_vector_type(4)));
typedef unsigned u32x4 __attribute__((ext_vector_type(4)));
constexpr int BM = 256, BK = 64, HALF = 128, HTB = HALF * BK * 2  , STAGE_BYTES = 8 * HTB, NXCD = 8, WGM = 8;

__host__ __device__ __forceinline__ int lds_byte(int r, int c) { const int st = (r >> 4) * 2 + (c >> 5), rr = r & 15, cc = c & 31, ob = rr * 64 + cc * 2; return st * 1024 + (ob ^ (((ob >> 9) & 1) << 5)); }
__host__ __device__ __forceinline__ void stage_rc(int b, int& R, int& C) { const int st = b / 1024, sb = b % 1024, swz = sb ^ (((sb >> 9) & 1) << 5); R = (st >> 1) * 16 + swz / 64; C = (st & 1) * 32 + (swz % 64) / 2; }
__host__ __device__ __forceinline__ int perm32(int rho) { const int n = rho >> 4, i = rho & 15; return 8 * (i >> 2) + 4 * n + (i & 3); }

struct Unit { int pm, pn; };
struct Gemm { const bf16_t* A; const bf16_t* Bt; int M, N, K; };

struct StaticOrder {
    int nM, nN, nwg, G, c;
    __host__ __device__ void init(int M, int N, int G_, int c_) { nM = M / BM; nN = N / BM; nwg = nM * nN; G = G_; c = c_; }
    __host__ __device__ bool next(int i, Unit& u) const {
        const long L = (long)i * G + c; if (L >= nwg) return false;
        int wgid = (int)L; { const int q = nwg / NXCD, r = nwg % NXCD, xcd = wgid % NXCD, off = wgid / NXCD; wgid = (xcd < r ? xcd * (q + 1) : r * (q + 1) + (xcd - r) * q) + off; }
        const int nig = WGM * nN, gid = wgid / nig, fm = gid * WGM, gsz = (nM - fm) < WGM ? (nM - fm) : WGM;
        u.pm = fm + ((wgid % nig) % gsz); u.pn = (wgid % nig) / gsz; return true;
    }
    __device__ __forceinline__ void a_ready(const Unit&) const {}
    __device__ __forceinline__ void done(const Unit&) const {}
};

__device__ __forceinline__ unsigned cvt_pk_bf16(float lo, float hi) { unsigned r; asm volatile("v_cvt_pk_bf16_f32 %0, %1, %2" : "=v"(r) : "v"(lo), "v"(hi)); return r; }
template <class Epi, class Sched, bool ALIGN_EPI = false, bool SP2 = false>
__device__ __forceinline__ void gemm_phase(PG8_LAS unsigned char* lds, const Gemm g, const Sched& S, const Epi& E) {
    const int tid = opaque_tid(), wid = __builtin_amdgcn_readfirstlane(tid >> 6), lane = tid & 63, wr = wid >> 2, wc = wid & 3, fr = lane & 15, fq = lane >> 4;
    const int K = g.K, nt = K / BK;
    unsigned voffA[2], voffB[2];
#pragma unroll
    for (int i = 0; i < 2; ++i) { int R, C; stage_rc(tid * 16 + i * 8192, R, C); const int Rb = Epi::PERM ? ((R & ~31) + perm32(R & 31)) : R;
        voffA[i] = (unsigned)(R * K + C) * 2u; voffB[i] = (unsigned)(Rb * K + C) * 2u; }
    const size_t kstep = (size_t)(BK * 2);
    const size_t hstep = (size_t)HALF * K * 2;
    const size_t tstep = 2 * hstep;
    const unsigned ldsw = (unsigned)wid * 1024u;
    const int aoff = lds_byte(wr * 64 + fr, fq * 8), boff = lds_byte(wc * 32 + fr, fq * 8);
#define PG8_SA(b, h) (((b) * 2 + (h)) * HTB)
#define PG8_SB(b, h) ((4 + (b) * 2 + (h)) * HTB)
#define PG8_STAGE(bufoff, gbase, voff) do { _Pragma("unroll") for (int _i = 0; _i < 2; ++_i) \
        __builtin_amdgcn_global_load_lds((const unsigned*)((const char*)(gbase) + (voff)[_i]), (PG8_LAS unsigned*)(lds + (bufoff) + ldsw + _i * 8192), 16, 0, 0); } while (0)
#define PG8_LDA(dst, b, h) do { _Pragma("unroll") for (int m = 0; m < 4; ++m) _Pragma("unroll") for (int k = 0; k < 2; ++k) dst[m][k] = *(const PG8_LAS bf16x8*)(lds + PG8_SA(b, h) + aoff + m * 2048 + k * 1024); } while (0)
#define PG8_LDB(dst, b, h) do { _Pragma("unroll") for (int n = 0; n < 2; ++n) _Pragma("unroll") for (int k = 0; k < 2; ++k) dst[n][k] = *(const PG8_LAS bf16x8*)(lds + PG8_SB(b, h) + boff + n * 2048 + k * 1024); } while (0)
#define PG8_MMA(ai, bj, At, Bt) do { __builtin_amdgcn_s_setprio(1); _Pragma("unroll") for (int m = 0; m < 4; ++m) _Pragma("unroll") for (int n = 0; n < 2; ++n) _Pragma("unroll") for (int k = 0; k < 2; ++k) \
        acc[ai][bj][m][n] = __builtin_amdgcn_mfma_f32_16x16x32_bf16(Bt[n][k], At[m][k], acc[ai][bj][m][n], 0, 0, 0); __builtin_amdgcn_s_setprio(0); } while (0)
#define PG8_WAIT_V(n) asm volatile("s_waitcnt vmcnt(" #n ")" ::: "memory")
#define PG8_WAIT_L(n) asm volatile("s_waitcnt lgkmcnt(" #n ")" ::: "memory")
#define PG8_BAR __builtin_amdgcn_s_barrier()
#define PG8_SCHED __builtin_amdgcn_sched_barrier(0)
    Unit cur, nxt; int ui = 0;
    if (!S.next(0, cur)) return;
    f32x4 acc[2][2][4][2];
#pragma unroll
    for (int a = 0; a < 2; ++a)
#pragma unroll
        for (int b = 0; b < 2; ++b)
#pragma unroll
            for (int m = 0; m < 4; ++m)
#pragma unroll
                for (int n = 0; n < 2; ++n) acc[a][b][m][n] = (f32x4){0.f, 0.f, 0.f, 0.f};
    bf16x8 At[4][2], B0[2][2], B1[2][2];
    const char* cA = (const char*)g.A + (size_t)cur.pm * tstep; const char* cB = (const char*)g.Bt + (size_t)cur.pn * tstep;
    S.a_ready(cur);
    if constexpr (SP2) {
        PG8_STAGE(PG8_SB(0, 0), cB, voffB); PG8_STAGE(PG8_SB(0, 1), cB + hstep, voffB); PG8_STAGE(PG8_SA(0, 0), cA, voffA); PG8_STAGE(PG8_SA(0, 1), cA + hstep, voffA);
        if (wr == 1) PG8_BAR;
        PG8_WAIT_V(2); PG8_BAR;
        PG8_STAGE(PG8_SB(1, 0), cB + kstep, voffB); PG8_STAGE(PG8_SA(1, 0), cA + kstep, voffA); PG8_STAGE(PG8_SB(1, 1), cB + hstep + kstep, voffB);
        PG8_WAIT_V(6); PG8_BAR;
    } else {
        PG8_STAGE(PG8_SB(0, 0), cB, voffB); PG8_STAGE(PG8_SA(0, 0), cA, voffA); PG8_STAGE(PG8_SB(0, 1), cB + hstep, voffB); PG8_STAGE(PG8_SA(0, 1), cA + hstep, voffA);
        if (wr == 1) PG8_BAR;
        PG8_WAIT_V(4); PG8_BAR;
        PG8_STAGE(PG8_SB(1, 0), cB + kstep, voffB); PG8_STAGE(PG8_SA(1, 0), cA + kstep, voffA); PG8_STAGE(PG8_SB(1, 1), cB + hstep + kstep, voffB);
        PG8_WAIT_V(6); PG8_BAR;
    }
    for (;;) {
        const bool has_next = S.next(ui + 1, nxt);
        const char* nA = has_next ? (const char*)g.A + (size_t)nxt.pm * tstep : cA; const char* nB = has_next ? (const char*)g.Bt + (size_t)nxt.pn * tstep : cB;
        for (int t = 0; t < nt; t += 2) {
            const bool last = (t == nt - 2);
            const char* a1 = cA + (size_t)(t + 1) * kstep;
            const char* a2 = last ? nA : cA + (size_t)(t + 2) * kstep; const char* b2 = last ? nB : cB + (size_t)(t + 2) * kstep;
            const char* a3 = a2 + kstep; const char* b3 = b2 + kstep;
            if (last && has_next) S.a_ready(nxt);
            if constexpr (SP2) {
            PG8_LDB(B0, 0, 0); PG8_LDB(B1, 0, 1); PG8_SCHED; PG8_LDA(At, 0, 0); PG8_STAGE(PG8_SA(1, 1), a1 + hstep, voffA);
            PG8_WAIT_V(8); PG8_WAIT_L(0); PG8_BAR; PG8_MMA(0, 0, At, B0); PG8_MMA(0, 1, At, B1); PG8_BAR; PG8_SCHED;
            PG8_LDA(At, 0, 1); PG8_STAGE(PG8_SB(0, 0), b2, voffB); PG8_STAGE(PG8_SB(0, 1), b2 + hstep, voffB); PG8_STAGE(PG8_SA(0, 0), a2, voffA);
            PG8_WAIT_V(8); PG8_WAIT_L(0); PG8_BAR; PG8_MMA(1, 0, At, B0); PG8_MMA(1, 1, At, B1); PG8_BAR; PG8_SCHED;
            PG8_LDB(B0, 1, 0); PG8_LDB(B1, 1, 1); PG8_SCHED; PG8_LDA(At, 1, 0); PG8_STAGE(PG8_SA(0, 1), a2 + hstep, voffA);
            PG8_WAIT_V(8); PG8_WAIT_L(0); PG8_BAR; PG8_MMA(0, 0, At, B0); PG8_MMA(0, 1, At, B1); PG8_BAR; PG8_SCHED;
            PG8_LDA(At, 1, 1); PG8_STAGE(PG8_SB(1, 0), b3, voffB); PG8_STAGE(PG8_SB(1, 1), b3 + hstep, voffB); PG8_STAGE(PG8_SA(1, 0), a3, voffA);
            PG8_WAIT_V(8); PG8_WAIT_L(0); PG8_BAR; PG8_MMA(1, 0, At, B0); PG8_MMA(1, 1, At, B1); PG8_BAR; PG8_SCHED;
            } else {
            PG8_LDB(B0, 0, 0); PG8_SCHED; PG8_LDA(At, 0, 0); PG8_STAGE(PG8_SA(1, 1), a1 + hstep, voffA);
            PG8_WAIT_L(8); PG8_BAR; PG8_WAIT_L(0); PG8_MMA(0, 0, At, B0); PG8_BAR; PG8_SCHED;
            PG8_LDB(B1, 0, 1); PG8_STAGE(PG8_SB(0, 0), b2, voffB);
            PG8_BAR; PG8_WAIT_L(0); PG8_MMA(0, 1, At, B1); PG8_BAR;
            PG8_LDA(At, 0, 1); PG8_STAGE(PG8_SA(0, 0), a2, voffA);
            PG8_BAR; PG8_WAIT_L(0); PG8_MMA(1, 0, At, B0); PG8_BAR; PG8_SCHED;
            PG8_STAGE(PG8_SB(0, 1), b2 + hstep, voffB);
            PG8_WAIT_V(6); PG8_BAR; PG8_MMA(1, 1, At, B1); PG8_BAR;
            PG8_LDB(B0, 1, 0); PG8_SCHED; PG8_LDA(At, 1, 0); PG8_STAGE(PG8_SA(0, 1), a2 + hstep, voffA);
            PG8_WAIT_L(8); PG8_BAR; PG8_WAIT_L(0); PG8_MMA(0, 0, At, B0); PG8_BAR; PG8_SCHED;
            PG8_LDB(B1, 1, 1); PG8_STAGE(PG8_SB(1, 0), b3, voffB);
            PG8_BAR; PG8_WAIT_L(0); PG8_MMA(0, 1, At, B1); PG8_BAR;
            PG8_LDA(At, 1, 1); PG8_STAGE(PG8_SA(1, 0), a3, voffA);
            PG8_BAR; PG8_WAIT_L(0); PG8_MMA(1, 0, At, B0); PG8_BAR; PG8_SCHED;
            PG8_STAGE(PG8_SB(1, 1), b3 + hstep, voffB);
            PG8_WAIT_V(6); PG8_BAR; PG8_MMA(1, 1, At, B1); PG8_BAR;
            }
        }
        if constexpr (ALIGN_EPI) { if (wr == 0) PG8_BAR; }
        if constexpr (!Epi::AFTER_DRAIN) { E(acc, cur, wr, wc, fr, fq); S.done(cur); }
        if (!has_next) break;
#pragma unroll
        for (int a = 0; a < 2; ++a)
#pragma unroll
            for (int b = 0; b < 2; ++b)
#pragma unroll
                for (int m = 0; m < 4; ++m)
#pragma unroll
                    for (int n = 0; n < 2; ++n) acc[a][b][m][n] = (f32x4){0.f, 0.f, 0.f, 0.f};
        cur = nxt; cA = nA; cB = nB; ++ui;
        if constexpr (ALIGN_EPI) { if (wr == 1) PG8_BAR; }
    }
    PG8_WAIT_V(0);
    if constexpr (!ALIGN_EPI) { if (wr == 0) PG8_BAR; }
    PG8_BAR;
    if constexpr (Epi::AFTER_DRAIN) { E.fused(acc, cur, wr, wc, fr, fq, lds, wid, lane); S.done(cur); }
#undef PG8_SA
#undef PG8_SB
#undef PG8_STAGE
#undef PG8_LDA
#undef PG8_LDB
#undef PG8_MMA
#undef PG8_WAIT_V
#undef PG8_WAIT_L
#undef PG8_BAR
#undef PG8_SCHED
}
}

#include <hip/hip_cooperative_groups.h>
namespace cg = cooperative_groups;

constexpr int T_ALL = 32768, SEQ = 8192, DM = 1024, TH = 16384;
constexpr float EPS = 1e-6f;
constexpr size_t MiB = 1u << 20;
constexpr size_t WS_SS = (186 + 292) * MiB;
constexpr size_t WS_W = 2 * MiB;
constexpr size_t W_AIN = WS_W, W_AOUT = WS_W + 36 * MiB, W_MIN = WS_W + 40 * MiB, W_MOUT = WS_W + 52 * MiB, W_UP = WS_W + 56 * MiB, W_DN = WS_W + 88 * MiB;
constexpr size_t WS_XB = 122 * MiB;
constexpr size_t WS_R = 186 * MiB;
constexpr size_t SEC = (size_t)TH * DM;
constexpr size_t R_LSE = 288 * MiB;
constexpr size_t R_GATES = 192 * MiB, R_STATE = 193 * MiB, R_SC = 226 * MiB, R_YM = 227 * MiB;
constexpr int ST_STRIDE = 32768 + 128;
constexpr size_t WS_NEED = 512 * MiB;
constexpr int LDS_BYTES = 147456;
constexpr int NPH = 35;
#define DBG_NPH NPH

#define LAS __attribute__((address_space(3)))
#define DI __device__ __forceinline__
typedef unsigned short bf16_t;
typedef short bf16x8 __attribute__((ext_vector_type(8)));
typedef float f32x4 __attribute__((ext_vector_type(4)));
typedef float f32x16 __attribute__((ext_vector_type(16)));
typedef unsigned u32x4 __attribute__((ext_vector_type(4)));
typedef unsigned u32x2 __attribute__((ext_vector_type(2)));

DI unsigned f2bf(float f) { unsigned u = __builtin_bit_cast(unsigned, f); return (u + 0x7fffu + ((u >> 16) & 1u)) >> 16; }
typedef float f32x2n __attribute__((ext_vector_type(2)));
typedef __bf16 bf16x2n __attribute__((ext_vector_type(2)));
DI unsigned pk2(float lo, float hi) { f32x2n v = {lo, hi}; bf16x2n b = __builtin_convertvector(v, bf16x2n); return __builtin_bit_cast(unsigned, b); }
DI float bflo(unsigned w) { return __builtin_bit_cast(float, w << 16); }
DI float bfhi(unsigned w) { return __builtin_bit_cast(float, w & 0xffff0000u); }
DI float wave_sum(float v);
DI float x16_sum(float x) { const unsigned u = __builtin_bit_cast(unsigned, x); auto r = __builtin_amdgcn_permlane16_swap(u, u, false, false); return __builtin_bit_cast(float, (unsigned)r[0]) + __builtin_bit_cast(float, (unsigned)r[1]); }
DI float x32_sum(float x) { const unsigned u = __builtin_bit_cast(unsigned, x); auto r = __builtin_amdgcn_permlane32_swap(u, u, false, false); return __builtin_bit_cast(float, (unsigned)r[0]) + __builtin_bit_cast(float, (unsigned)r[1]); }
DI float x16_max(float x) { const unsigned u = __builtin_bit_cast(unsigned, x); auto r = __builtin_amdgcn_permlane16_swap(u, u, false, false); return fmaxf(__builtin_bit_cast(float, (unsigned)r[0]), __builtin_bit_cast(float, (unsigned)r[1])); }
DI float x32_max(float x) { const unsigned u = __builtin_bit_cast(unsigned, x); auto r = __builtin_amdgcn_permlane32_swap(u, u, false, false); return fmaxf(__builtin_bit_cast(float, (unsigned)r[0]), __builtin_bit_cast(float, (unsigned)r[1])); }
template <int CTRL, int ROWMASK> DI float dpp_mov(float old, float x) { return __builtin_bit_cast(float, __builtin_amdgcn_update_dpp(__builtin_bit_cast(int, old), __builtin_bit_cast(int, x), CTRL, ROWMASK, 0xf, false)); }
DI float wave_scan_sum(float v) {
    v += dpp_mov<0x111, 0xf>(0.f, v); v += dpp_mov<0x112, 0xf>(0.f, v); v += dpp_mov<0x114, 0xf>(0.f, v); v += dpp_mov<0x118, 0xf>(0.f, v);
    v += dpp_mov<0x142, 0xa>(0.f, v); v += dpp_mov<0x143, 0xc>(0.f, v); return v; }
DI float wave_scan_max(float v) { const float ninf = -INFINITY;
    v = fmaxf(v, dpp_mov<0x111, 0xf>(ninf, v)); v = fmaxf(v, dpp_mov<0x112, 0xf>(ninf, v)); v = fmaxf(v, dpp_mov<0x114, 0xf>(ninf, v)); v = fmaxf(v, dpp_mov<0x118, 0xf>(ninf, v));
    v = fmaxf(v, dpp_mov<0x142, 0xa>(ninf, v)); v = fmaxf(v, dpp_mov<0x143, 0xc>(ninf, v)); return v; }
DI float row_sum16(float v) { v += dpp_mov<0x128, 0xf>(v, v); v += dpp_mov<0x124, 0xf>(v, v); v += dpp_mov<0x122, 0xf>(v, v); v += dpp_mov<0x121, 0xf>(v, v); return v; }
DI float lane_xor1(float v) { return dpp_mov<0xB1, 0xf>(v, v); }
DI float lane_xor2(float v) { return dpp_mov<0x4E, 0xf>(v, v); }
DI float lane_xor4(float v, int lane) { const float a = dpp_mov<0x104, 0xf>(v, v), b = dpp_mov<0x114, 0xf>(v, v); return (lane & 4) ? b : a; }
DI float lane_xor8(float v) { return dpp_mov<0x128, 0xf>(v, v); }
DI float wave_sum(float v) { return x32_sum(x16_sum(row_sum16(v))); }
DI float frcp(float x) { return __builtin_amdgcn_rcpf(x); }
DI float frsq(float x) { return __builtin_amdgcn_rsqf(x); }
typedef long long ss_t;
DI float ss_get(const ss_t* ss, int r) { return (float)ss[r] * (1.0f / 1048576.0f); }
DI void ss_add(ss_t* ss, int r, float v) { atomicAdd((unsigned long long*)(ss + r), (unsigned long long)__float2ll_rn(v * 1048576.0f)); }
DI void lds_wait() { asm volatile("s_waitcnt lgkmcnt(0)" ::: "memory"); }
DI void lbar() { asm volatile("s_waitcnt lgkmcnt(0)" ::: "memory"); __builtin_amdgcn_s_barrier(); asm volatile("" ::: "memory"); }

namespace pg8 {
struct EpiScale {
    static constexpr bool PERM = true, AFTER_DRAIN = false;
    bf16_t* O; int ldc; const long long* ss; int mode; const float* qg; const float* kg;
    __device__ __forceinline__ void operator()(const f32x4 (&acc)[2][2][4][2], const Unit& u, int wr, int wc, int fr, int fq) const {
        const int row0 = u.pm * BM + wr * 64 + fr;
        const int colt = u.pn * BM;
        if (mode == 0) {
            const int blk = colt >> 10, g = blk % 3, sec = blk / 3; const int dsh = (g == 0) ? 0 : (g == 1 ? 2 : 4); const int cin = (colt & 1023) + 64 * wc + 8 * fq;
            f32x4 gn[2][2];
            const float* gp = (sec == 0) ? qg + g * 64 : kg + g * 64;
#pragma unroll
            for (int bj = 0; bj < 2; ++bj)
#pragma unroll
                for (int n = 0; n < 2; ++n) gn[bj][n] = (sec < 2) ? *(const f32x4*)(gp + 32 * bj + 8 * fq + 4 * n) : (f32x4){1.f, 1.f, 1.f, 1.f};
            const float qsc = (sec == 0) ? 0.125f * 1.4426950408889634f : 1.0f;
#pragma unroll
            for (int ai = 0; ai < 2; ++ai)
#pragma unroll
                for (int m = 0; m < 4; ++m) {
                    const int r = row0 + ai * HALF + m * 16;
                    const float rs = __builtin_amdgcn_rsqf((float)ss[r] * (1.0f / 1048576.0f) * (1.0f / 1024.0f) + EPS);
                    f32x4 v[2][2]; float sq = 0.f;
#pragma unroll
                    for (int bj = 0; bj < 2; ++bj)
#pragma unroll
                        for (int n = 0; n < 2; ++n) { v[bj][n] = acc[ai][bj][m][n] * rs; sq += (v[bj][n][0] * v[bj][n][0] + v[bj][n][1] * v[bj][n][1]) + (v[bj][n][2] * v[bj][n][2] + v[bj][n][3] * v[bj][n][3]); }
                    sq = x16_sum(sq); sq = x32_sum(sq);
                    const float r2 = (sec < 2) ? qsc * __builtin_amdgcn_rsqf(sq * (1.0f / 64.0f) + EPS) : 1.0f;
                    const int bl = r >> 13, t = r & 8191; const int pr = (bl << 13) + ((t & ((1 << dsh) - 1)) << (13 - dsh)) + (t >> dsh);
                    bf16_t* rowp = O + (size_t)blk * SEC + (size_t)pr * 1024 + cin;
#pragma unroll
                    for (int bj = 0; bj < 2; ++bj) { const f32x4 v0 = v[bj][0] * gn[bj][0] * r2, v1 = v[bj][1] * gn[bj][1] * r2;
                        u32x4 w; w.x = cvt_pk_bf16(v0[0], v0[1]); w.y = cvt_pk_bf16(v0[2], v0[3]); w.z = cvt_pk_bf16(v1[0], v1[1]); w.w = cvt_pk_bf16(v1[2], v1[3]);
                        *(u32x4*)(rowp + bj * 32) = w; }
                }
            return;
        }
#pragma unroll
        for (int ai = 0; ai < 2; ++ai)
#pragma unroll
            for (int m = 0; m < 4; ++m) {
                const int r = row0 + ai * HALF + m * 16;
                const float rs = __builtin_amdgcn_rsqf((float)ss[r] * (1.0f / 1048576.0f) * (1.0f / 1024.0f) + EPS);
                bf16_t* rowp = O + (size_t)r * ldc + colt + wc * 32 + 8 * fq;
#pragma unroll
                for (int bj = 0; bj < 2; ++bj) { f32x4 v0 = acc[ai][bj][m][0] * rs, v1 = acc[ai][bj][m][1] * rs;
                    if (mode == 2) {
#pragma unroll
                        for (int e = 0; e < 4; ++e) { float a = fmaxf(v0[e], 0.f), b = fmaxf(v1[e], 0.f); v0[e] = a * a; v1[e] = b * b; } }
                    if (mode == 1 && colt >= 2048) {
#pragma unroll
                        for (int e = 0; e < 4; ++e) { v0[e] = __builtin_amdgcn_rcpf(1.0f + __builtin_amdgcn_exp2f(-1.4426950408889634f * v0[e])); v1[e] = __builtin_amdgcn_rcpf(1.0f + __builtin_amdgcn_exp2f(-1.4426950408889634f * v1[e])); } }
                    u32x4 w; w.x = cvt_pk_bf16(v0[0], v0[1]); w.y = cvt_pk_bf16(v0[2], v0[3]); w.z = cvt_pk_bf16(v1[0], v1[1]); w.w = cvt_pk_bf16(v1[2], v1[3]);
                    *(u32x4*)(rowp + bj * HALF) = w; }
            }
    }
};
struct EpiRes {
    static constexpr bool PERM = true, AFTER_DRAIN = false;
    float* X; bf16_t* XB; long long* ssn; int row_base;
    __device__ __forceinline__ void operator()(const f32x4 (&acc)[2][2][4][2], const Unit& u, int wr, int wc, int fr, int fq) const {
        const int row0 = row_base + u.pm * BM + wr * 64 + fr;
        const int col0 = u.pn * BM + wc * 32 + 8 * fq;
        u32x4 pre[2][4][2];
#pragma unroll
        for (int ai = 0; ai < 2; ++ai)
#pragma unroll
            for (int m = 0; m < 4; ++m)
#pragma unroll
                for (int bj = 0; bj < 2; ++bj) pre[ai][m][bj] = *(const u32x4*)(XB + (size_t)(row0 + ai * HALF + m * 16) * 1024 + col0 + bj * HALF);
#pragma unroll
        for (int ai = 0; ai < 2; ++ai)
#pragma unroll
            for (int m = 0; m < 4; ++m) {
                const int r = row0 + ai * HALF + m * 16; const size_t off = (size_t)r * 1024 + col0; float s = 0.f;
#pragma unroll
                for (int bj = 0; bj < 2; ++bj) {
                    const u32x4 bw = pre[ai][m][bj];
                    f32x4 b0, b1; b0[0] = __builtin_bit_cast(float, bw.x << 16); b0[1] = __builtin_bit_cast(float, bw.x & 0xffff0000u); b0[2] = __builtin_bit_cast(float, bw.y << 16); b0[3] = __builtin_bit_cast(float, bw.y & 0xffff0000u);
                    b1[0] = __builtin_bit_cast(float, bw.z << 16); b1[1] = __builtin_bit_cast(float, bw.z & 0xffff0000u); b1[2] = __builtin_bit_cast(float, bw.w << 16); b1[3] = __builtin_bit_cast(float, bw.w & 0xffff0000u);
                    const f32x4 v0 = b0 + acc[ai][bj][m][0], v1 = b1 + acc[ai][bj][m][1];
                    if (X) { *(f32x4*)(X + off + bj * HALF) = v0; *(f32x4*)(X + off + bj * HALF + 4) = v1; }
                    s += (v0[0] * v0[0] + v0[1] * v0[1]) + (v0[2] * v0[2] + v0[3] * v0[3]) + (v1[0] * v1[0] + v1[1] * v1[1]) + (v1[2] * v1[2] + v1[3] * v1[3]);
                    u32x4 w; w.x = cvt_pk_bf16(v0[0], v0[1]); w.y = cvt_pk_bf16(v0[2], v0[3]); w.z = cvt_pk_bf16(v1[0], v1[1]); w.w = cvt_pk_bf16(v1[2], v1[3]);
                    *(u32x4*)(XB + off + bj * HALF) = w; }
                s = x16_sum(s); s = x32_sum(s);
                if (fq == 0 && ssn) atomicAdd((unsigned long long*)(ssn + r), (unsigned long long)__float2ll_rn(s * 1048576.0f));
            }
    }
};
}

DI void transpose_item(const float* W, int ldw, int K, int nblk, const float* g, bf16_t* WT, LAS float* scr, int item, int lane, bool hperm) {
    const int kb = item / nblk, nb = item % nblk, k0 = 64 * kb, n0 = 64 * nb;
    const int kr = lane >> 4, n4 = (lane & 15) * 4;
    f32x4 v[16];
#pragma unroll
    for (int i = 0; i < 16; ++i) v[i] = __builtin_nontemporal_load((const f32x4*)(W + (size_t)(k0 + 4 * i + kr) * ldw + n0 + n4));
    if (g) {
#pragma unroll
        for (int i = 0; i < 16; ++i) v[i] = v[i] * g[k0 + 4 * i + kr];
    }
#pragma unroll
    for (int i = 0; i < 16; ++i) { LAS float* p = scr + (4 * i + kr) * 65 + n4; p[0] = v[i][0]; p[1] = v[i][1]; p[2] = v[i][2]; p[3] = v[i][3]; }
    lds_wait();
    const int c = lane & 7;
#pragma unroll
    for (int j = 0; j < 8; ++j) { const int n = (lane >> 3) + 8 * j; const LAS float* s = scr + (8 * c) * 65 + n;
        u32x4 o; o.x = pk2(s[0 * 65], s[1 * 65]); o.y = pk2(s[2 * 65], s[3 * 65]); o.z = pk2(s[4 * 65], s[5 * 65]); o.w = pk2(s[6 * 65], s[7 * 65]);
        int nr = n0 + n; if (hperm) nr = (nr & ~255) | (((nr >> 5) & 1) << 7) | (((nr >> 6) & 3) << 5) | (nr & 31);
        *(u32x4*)(WT + (size_t)nr * K + k0 + 8 * c) = o; }
    lds_wait();
}

struct Args { const float* in[16]; float* out; unsigned char* ws; int ph_lo, ph_hi; };

DI void prologue(const Args& a, LAS unsigned char* lds, int G, int bid) {
    const int tid = opaque_tid(), lane = tid & 63, wave = tid >> 6;
    LAS float* scr = (LAS float*)(lds + wave * 16640);
    const int gw = bid * 8 + wave, NGW = G * 8;
    unsigned char* ws = a.ws;
    int base = 0;
#pragma unroll 1
    for (int mi = 0; mi < 16; ++mi) {
        const float* W; int ldw, K, N; const float* g; bf16_t* WT;
        if (mi < 2)       { W = a.in[4] + (size_t)mi * 1024 * 9216; ldw = 9216; K = 1024; N = 9216; g = a.in[1] + (2 * mi) * 1024; WT = (bf16_t*)(ws + W_AIN + (size_t)mi * 18 * MiB); }
        else if (mi < 4)  { const int j = mi - 2; W = a.in[7] + (size_t)j * 1024 * 1024; ldw = 1024; K = 1024; N = 1024; g = nullptr; WT = (bf16_t*)(ws + W_AOUT + (size_t)j * 2 * MiB); }
        else if (mi < 6)  { const int j = mi - 4; W = a.in[8] + (size_t)j * 1024 * 3080; ldw = 3080; K = 1024; N = 3072; g = a.in[1] + (2 * j + 1) * 1024; WT = (bf16_t*)(ws + W_MIN + (size_t)j * 6 * MiB); }
        else if (mi < 8)  { const int j = mi - 6; W = a.in[13] + (size_t)j * 1024 * 1024; ldw = 1024; K = 1024; N = 1024; g = nullptr; WT = (bf16_t*)(ws + W_MOUT + (size_t)j * 2 * MiB); }
        else if (mi < 12) { const int l = mi - 8; W = a.in[14] + (size_t)l * 1024 * 4096; ldw = 4096; K = 1024; N = 4096; g = a.in[2] + l * 1024; WT = (bf16_t*)(ws + W_UP + (size_t)l * 8 * MiB); }
        else              { const int l = mi - 12; W = a.in[15] + (size_t)l * 4096 * 1024; ldw = 1024; K = 4096; N = 1024; g = nullptr; WT = (bf16_t*)(ws + W_DN + (size_t)l * 8 * MiB); }
        const int nblk = N / 64, nit = (K / 64) * nblk;
        int first = (gw - (base % NGW) + NGW) % NGW;
        for (int it = first; it < nit; it += NGW) transpose_item(W, ldw, K, nblk, g, WT, scr, it, lane, mi < 2);
        base += nit;
    }
    const float* x = a.in[0]; bf16_t* XB = (bf16_t*)(ws + WS_XB); ss_t* ss = (ss_t*)(ws + WS_SS);
    for (int m0 = gw; m0 < T_ALL; m0 += 4 * NGW) {
        f32x4 v[4][4]; float sq[4];
#pragma unroll
        for (int r = 0; r < 4; ++r) { const int m = m0 + r * NGW; const f32x4* xr = (const f32x4*)(x + (size_t)m * 1024) + lane;
#pragma unroll
            for (int j = 0; j < 4; ++j) v[r][j] = __builtin_nontemporal_load(xr + 64 * j); }
#pragma unroll
        for (int r = 0; r < 4; ++r) { float s = 0.f;
#pragma unroll
            for (int j = 0; j < 4; ++j) s += (v[r][j].x * v[r][j].x + v[r][j].y * v[r][j].y) + (v[r][j].z * v[r][j].z + v[r][j].w * v[r][j].w);
            sq[r] = wave_sum(s); }
#pragma unroll
        for (int r = 0; r < 4; ++r) { const int m = m0 + r * NGW;
            if (lane == 0) ss[m] = __float2ll_rn(sq[r] * 1048576.0f);
            u32x2* o8 = (u32x2*)(XB + (size_t)m * 1024) + lane;
#pragma unroll
            for (int j = 0; j < 4; ++j) { u32x2 w; w.x = pk2(v[r][j].x, v[r][j].y); w.y = pk2(v[r][j].z, v[r][j].w); o8[64 * j] = w; } }
    }
    for (int i = bid * 512 + tid; i < 7 * T_ALL; i += G * 512) ss[T_ALL + i] = 0;
}

DI float bucket_bias(const float* relb, int dist, int g, int h) {
    int bk;
    if (dist < 16) bk = dist;
    else { const float dd = (float)dist; int lg = 16 + (int)(logf(dd / 16.0f) / 4.852030263919617f * 16.0f); bk = lg < 31 ? lg : 31; }
    return relb[(bk * 3 + g) * 16 + h];
}

DI void attn_unit_ptrs(int u, int& rn, int& h, int& g, int& d, int& n, size_t& rowbase) {
    rn = u & 63; h = (u >> 6) & 15; g = (u >> 10) % 3; const int bl = u / 3072;
    d = (g == 0) ? 1 : (g == 1 ? 4 : 16); n = rn % (64 / d); rowbase = (size_t)(bl * 8192 + rn * 128);
}
DI u32x4 norm_pack(const u32x4 raw, const float* gain, float scale) {
    float f[8] = {bflo(raw.x), bfhi(raw.x), bflo(raw.y), bfhi(raw.y), bflo(raw.z), bfhi(raw.z), bflo(raw.w), bfhi(raw.w)};
    float s = 0.f;
#pragma unroll
    for (int j = 0; j < 8; ++j) s += f[j] * f[j];
    s += __shfl_xor(s, 1); s += __shfl_xor(s, 2); s += __shfl_xor(s, 4);
    const float rs = scale * frsq(s * (1.0f / 64.0f) + EPS);
    const f32x4 g0 = *(const f32x4*)gain, g1 = *(const f32x4*)(gain + 4);
    u32x4 o; o.x = pk2(f[0] * rs * g0[0], f[1] * rs * g0[1]); o.y = pk2(f[2] * rs * g0[2], f[3] * rs * g0[3]); o.z = pk2(f[4] * rs * g1[0], f[5] * rs * g1[1]); o.w = pk2(f[6] * rs * g1[2], f[7] * rs * g1[3]);
    return o;
}
DI void vt_store(LAS unsigned* dst, const u32x4 r0, const u32x4 r1) {
    dst[0 * 132] = (r0.x & 0xffffu) | (r1.x << 16); dst[1 * 132] = (r0.x >> 16) | (r1.x & 0xffff0000u);
    dst[2 * 132] = (r0.y & 0xffffu) | (r1.y << 16); dst[3 * 132] = (r0.y >> 16) | (r1.y & 0xffff0000u);
    dst[4 * 132] = (r0.z & 0xffffu) | (r1.z << 16); dst[5 * 132] = (r0.z >> 16) | (r1.z & 0xffff0000u);
    dst[6 * 132] = (r0.w & 0xffffu) | (r1.w << 16); dst[7 * 132] = (r0.w >> 16) | (r1.w & 0xffff0000u);
}

DI void attn_phase(LAS unsigned char* lds, bf16_t* QKV, float* LSE, const float* qg, const float* kg, const float* relb, int G, int bid) {
    const int tid = opaque_tid(), lane = tid & 63, w = tid >> 6, fr = lane & 15, fq = lane >> 4;
    LAS bf16_t* Qs = (LAS bf16_t*)lds;
    LAS bf16_t* Ks = Qs + 128 * 72;
    LAS unsigned* Vt32 = (LAS unsigned*)(Ks + 256 * 72);
    LAS bf16_t* Vt = (LAS bf16_t*)Vt32;
    LAS float* tab = (LAS float*)(Vt32 + 64 * 132);
    const int per = (6144 + G - 1) / G; const int u0 = bid * per; int u1 = u0 + per; if (u1 > 6144) u1 = 6144;
    const int kp2 = tid & 63, vpc = tid >> 6;
    u32x4 pq[2], pk[2], pv[2];
    int rn, h, g, d, n; size_t rowbase;
    if (u0 < u1) { attn_unit_ptrs(u0, rn, h, g, d, n, rowbase);
        const bf16_t* qp = QKV + (size_t)g * SEC + rowbase * 1024 + h * 64; const bf16_t* kp = qp + 3 * SEC; const bf16_t* vp = qp + 6 * SEC;
#pragma unroll
        for (int it = 0; it < 2; ++it) { const int idx = tid + 512 * it, row = idx >> 3, pc = idx & 7; pq[it] = *(const u32x4*)(qp + (size_t)row * 1024 + pc * 8); pk[it] = *(const u32x4*)(kp + (size_t)row * 1024 + pc * 8); }
        pv[0] = *(const u32x4*)(vp + (size_t)(2 * kp2) * 1024 + vpc * 8); pv[1] = *(const u32x4*)(vp + (size_t)(2 * kp2 + 1) * 1024 + vpc * 8); }
    for (int u = u0; u < u1; ++u) {
        attn_unit_ptrs(u, rn, h, g, d, n, rowbase);
        bf16_t* qp = QKV + (size_t)g * SEC + rowbase * 1024 + h * 64;
        const int slot = n & 1;
        lbar();
        if (u == u0 || n == 0) { if (tid < 160) tab[tid] = (tid >= 16 && tid <= 144) ? 1.4426950408889634f * bucket_bias(relb, (tid - 16) * d, g, h) : 0.f; }
        if (n == 0) {
#pragma unroll
            for (int i = 0; i < 8; ++i) { const int idx = tid + 512 * i; Vt32[(idx >> 6) * 132 + (slot ^ 1) * 64 + (idx & 63)] = 0u; }
        } else if (u == u0) {
            const bf16_t* kp = qp + 3 * SEC - (size_t)128 * 1024; const bf16_t* vp = qp + 6 * SEC - (size_t)128 * 1024;
#pragma unroll
            for (int it = 0; it < 2; ++it) { const int idx = tid + 512 * it, row = idx >> 3, pc = idx & 7;
                const u32x4 raw = *(const u32x4*)(kp + (size_t)row * 1024 + pc * 8);
                *(LAS u32x4*)(Ks + ((slot ^ 1) * 128 + row) * 72 + pc * 8) = raw; }
            const u32x4 r0 = *(const u32x4*)(vp + (size_t)(2 * kp2) * 1024 + vpc * 8), r1 = *(const u32x4*)(vp + (size_t)(2 * kp2 + 1) * 1024 + vpc * 8);
            vt_store(Vt32 + (8 * vpc) * 132 + (slot ^ 1) * 64 + kp2, r0, r1);
        }
#pragma unroll
        for (int it = 0; it < 2; ++it) { const int idx = tid + 512 * it, row = idx >> 3, pc = idx & 7;
            *(LAS u32x4*)(Qs + row * 72 + pc * 8) = pq[it];
            *(LAS u32x4*)(Ks + (slot * 128 + row) * 72 + pc * 8) = pk[it]; }
        vt_store(Vt32 + (8 * vpc) * 132 + slot * 64 + kp2, pv[0], pv[1]);
        lbar();
        if (u + 1 < u1) {
            int rn2, h2, g2, d2, n2; size_t rb2; attn_unit_ptrs(u + 1, rn2, h2, g2, d2, n2, rb2);
            const bf16_t* qp2 = QKV + (size_t)g2 * SEC + rb2 * 1024 + h2 * 64; const bf16_t* kp2p = qp2 + 3 * SEC; const bf16_t* vp2 = qp2 + 6 * SEC;
#pragma unroll
            for (int it = 0; it < 2; ++it) { const int idx = tid + 512 * it, row = idx >> 3, pc = idx & 7; pq[it] = *(const u32x4*)(qp2 + (size_t)row * 1024 + pc * 8); pk[it] = *(const u32x4*)(kp2p + (size_t)row * 1024 + pc * 8); }
            pv[0] = *(const u32x4*)(vp2 + (size_t)(2 * kp2) * 1024 + vpc * 8); pv[1] = *(const u32x4*)(vp2 + (size_t)(2 * kp2 + 1) * 1024 + vpc * 8);
        }
        bf16x8 qf[2];
        qf[0] = *(const LAS bf16x8*)(Qs + (16 * w + fr) * 72 + 8 * fq); qf[1] = *(const LAS bf16x8*)(Qs + (16 * w + fr) * 72 + 32 + 8 * fq);
        f32x4 sc[9];
#pragma unroll
        for (int i = 0; i < 9; ++i) { const int tau = w + i; const int kr = ((((n + 1 + (tau >> 3)) & 1) << 7) | ((tau & 7) << 4)) + fr; f32x4 acc = (f32x4){0.f, 0.f, 0.f, 0.f};
            const bf16x8 a0 = *(const LAS bf16x8*)(Ks + kr * 72 + 8 * fq), a1 = *(const LAS bf16x8*)(Ks + kr * 72 + 32 + 8 * fq);
            acc = __builtin_amdgcn_mfma_f32_16x16x32_bf16(a0, qf[0], acc, 0, 0, 0);
            acc = __builtin_amdgcn_mfma_f32_16x16x32_bf16(a1, qf[1], acc, 0, 0, 0);
            sc[i] = acc; }
        float mx = -INFINITY;
        const LAS float* tb = tab + (16 + fr - 4 * fq - 3);
        const int dlt = fr - 4 * fq;
        float bv[9][4];
#pragma unroll
        for (int i = 0; i < 9; ++i)
#pragma unroll
            for (int j = 0; j < 4; ++j) bv[i][j] = tb[16 * (8 - i) + (3 - j)];
#pragma unroll
        for (int i = 0; i < 9; ++i)
#pragma unroll
            for (int j = 0; j < 4; ++j) asm volatile("" : "+v"(bv[i][j]));
#pragma unroll
        for (int i = 0; i < 9; ++i) { const bool tv = (n > 0) || (w + i >= 8);
#pragma unroll
            for (int j = 0; j < 4; ++j) { bool valid = tv;
                if (i == 0) valid = valid && (dlt - j <= 0);
                if (i == 8) valid = valid && (dlt - j >= 0);
                const float v = valid ? sc[i][j] + bv[i][j] : -INFINITY; sc[i][j] = v; mx = fmaxf(mx, v); } }
        mx = x16_max(mx); mx = x32_max(mx);
        float sum = 0.f;
#pragma unroll
        for (int i = 0; i < 9; ++i)
#pragma unroll
            for (int j = 0; j < 4; ++j) { const float p = __builtin_amdgcn_exp2f(sc[i][j] - mx); sc[i][j] = p; sum += p; }
        sum = x16_sum(sum); sum = x32_sum(sum);
        f32x4 o[4];
#pragma unroll
        for (int et = 0; et < 4; ++et) o[et] = (f32x4){0.f, 0.f, 0.f, 0.f};
#pragma unroll
        for (int pi = 0; pi < 5; ++pi) { const int ia = 2 * pi, ib = (2 * pi + 1 < 9) ? 2 * pi + 1 : 8;
            u32x4 pw; pw.x = pk2(sc[ia][0], sc[ia][1]); pw.y = pk2(sc[ia][2], sc[ia][3]);
            if (2 * pi + 1 < 9) { pw.z = pk2(sc[ib][0], sc[ib][1]); pw.w = pk2(sc[ib][2], sc[ib][3]); } else { pw.z = 0u; pw.w = 0u; }
            const bf16x8 pb = __builtin_bit_cast(bf16x8, pw);
            const int ta = w + ia; int tb = w + 2 * pi + 1; if (tb > 15) tb = 15;
            const int ca = ((((n + 1 + (ta >> 3)) & 1) << 7) | ((ta & 7) << 4)) + 4 * fq, cb = ((((n + 1 + (tb >> 3)) & 1) << 7) | ((tb & 7) << 4)) + 4 * fq;
#pragma unroll
            for (int et = 0; et < 4; ++et) { const LAS bf16_t* vr = Vt + (16 * et + fr) * 264;
                const u32x2 lo = *(const LAS u32x2*)(vr + ca), hi = *(const LAS u32x2*)(vr + cb);
                u32x4 aw; aw.x = lo.x; aw.y = lo.y; aw.z = hi.x; aw.w = hi.y;
                o[et] = __builtin_amdgcn_mfma_f32_16x16x32_bf16(__builtin_bit_cast(bf16x8, aw), pb, o[et], 0, 0, 0); } }
        const float inv = frcp(sum);
        bf16_t* orow = qp + (size_t)(16 * w + fr) * 1024 + 4 * fq;
#pragma unroll
        for (int et = 0; et < 4; ++et) { u32x2 ow; ow.x = pk2(o[et][0] * inv, o[et][1] * inv); ow.y = pk2(o[et][2] * inv, o[et][3] * inv); *(u32x2*)(orow + 16 * et) = ow; }
        if (fq == 0) LSE[((size_t)g * TH + rowbase + 16 * w + fr) * 16 + h] = (mx + __log2f(sum)) * 0.6931471805599453f;
    }
}

DI void merge_phase(bf16_t* QKV, const float* LSE, int G, int bid) {
    const int tid = opaque_tid(), lane = tid & 63, gw = bid * 8 + (tid >> 6), NGW = G * 8;
    const int h = lane >> 2, col = 16 * lane;
    for (int tl0 = gw; tl0 < TH; tl0 += 4 * NGW) {
        u32x4 a[4][2], b[4][2], c[4][2]; float l0[4], l1[4], l2[4]; bf16_t* p0[4];
#pragma unroll
        for (int r = 0; r < 4; ++r) { const int tl = tl0 + r * NGW; const int bl = tl >> 13, t = tl & 8191;
            const int pr0 = tl, pr1 = (bl << 13) + ((t & 3) << 11) + (t >> 2), pr2 = (bl << 13) + ((t & 15) << 9) + (t >> 4);
            l0[r] = LSE[((size_t)0 * TH + pr0) * 16 + h]; l1[r] = LSE[((size_t)1 * TH + pr1) * 16 + h]; l2[r] = LSE[((size_t)2 * TH + pr2) * 16 + h];
            p0[r] = QKV + (size_t)pr0 * 1024 + col; const bf16_t* p1 = QKV + SEC + (size_t)pr1 * 1024 + col; const bf16_t* p2 = QKV + 2 * SEC + (size_t)pr2 * 1024 + col;
#pragma unroll
            for (int q = 0; q < 2; ++q) { a[r][q] = *(const u32x4*)(p0[r] + 8 * q); b[r][q] = *(const u32x4*)(p1 + 8 * q); c[r][q] = *(const u32x4*)(p2 + 8 * q); } }
#pragma unroll
        for (int r = 0; r < 4; ++r) {
            const float m = fmaxf(l0[r], fmaxf(l1[r], l2[r])); float w0 = __expf(l0[r] - m), w1 = __expf(l1[r] - m), w2 = __expf(l2[r] - m); const float is = frcp(w0 + w1 + w2); w0 *= is; w1 *= is; w2 *= is;
#pragma unroll
            for (int q = 0; q < 2; ++q) { const u32x4 A = a[r][q], B = b[r][q], C = c[r][q]; u32x4 o;
                o.x = pk2(w0 * bflo(A.x) + w1 * bflo(B.x) + w2 * bflo(C.x), w0 * bfhi(A.x) + w1 * bfhi(B.x) + w2 * bfhi(C.x));
                o.y = pk2(w0 * bflo(A.y) + w1 * bflo(B.y) + w2 * bflo(C.y), w0 * bfhi(A.y) + w1 * bfhi(B.y) + w2 * bfhi(C.y));
                o.z = pk2(w0 * bflo(A.z) + w1 * bflo(B.z) + w2 * bflo(C.z), w0 * bfhi(A.z) + w1 * bfhi(B.z) + w2 * bfhi(C.z));
                o.w = pk2(w0 * bflo(A.w) + w1 * bflo(B.w) + w2 * bflo(C.w), w0 * bfhi(A.w) + w1 * bfhi(B.w) + w2 * bfhi(C.w));
                *(u32x4*)(p0[r] + 8 * q) = o; }
        }
    }
}

DI void gates_phase(LAS unsigned char* lds, const bf16_t* X, const ss_t* ss, const float* win  , const float* ng, const float* gbias, float* GATES, int G, int bid) {
    const int tid = opaque_tid(), lane = tid & 63, gw = bid * 8 + (tid >> 6), NGW = G * 8;
    LAS float* wg = (LAS float*)lds;
    __syncthreads();
    for (int k = tid; k < 1024; k += 512) { const float gv = ng[k]; const f32x4 a = *(const f32x4*)(win + (size_t)k * 3080 + 3072), b = *(const f32x4*)(win + (size_t)k * 3080 + 3076);
        *(LAS f32x4*)(wg + k * 8) = a * gv; *(LAS f32x4*)(wg + k * 8 + 4) = b * gv; }
    __syncthreads();
    for (int m0 = gw; m0 < T_ALL; m0 += 2 * NGW) {
        float acc[2][8];
#pragma unroll
        for (int r = 0; r < 2; ++r)
#pragma unroll
            for (int j = 0; j < 8; ++j) acc[r][j] = 0.f;
        const bf16_t* xr0 = X + (size_t)m0 * 1024; const bf16_t* xr1 = X + (size_t)(m0 + NGW) * 1024;
#pragma unroll 4
        for (int i = 0; i < 16; ++i) { const int k = lane + 64 * i; const float x0 = __builtin_bit_cast(float, (unsigned)xr0[k] << 16), x1 = __builtin_bit_cast(float, (unsigned)xr1[k] << 16); const f32x4 a = *(const LAS f32x4*)(wg + k * 8), b = *(const LAS f32x4*)(wg + k * 8 + 4);
#pragma unroll
            for (int e = 0; e < 4; ++e) { acc[0][e] += x0 * a[e]; acc[0][4 + e] += x0 * b[e]; acc[1][e] += x1 * a[e]; acc[1][4 + e] += x1 * b[e]; } }
#pragma unroll
        for (int r = 0; r < 2; ++r) {
            float v4[4], v2[2], v1;
            { const bool up = lane & 1;
#pragma unroll
              for (int e = 0; e < 4; ++e) { const float keep = up ? acc[r][4 + e] : acc[r][e], send = up ? acc[r][e] : acc[r][4 + e]; v4[e] = keep + lane_xor1(send); } }
            { const bool up = lane & 2;
#pragma unroll
              for (int e = 0; e < 2; ++e) { const float keep = up ? v4[2 + e] : v4[e], send = up ? v4[e] : v4[2 + e]; v2[e] = keep + lane_xor2(send); } }
            { const bool up = lane & 4; const float keep = up ? v2[1] : v2[0], send = up ? v2[0] : v2[1]; v1 = keep + lane_xor4(send, lane); }
            v1 += lane_xor8(v1); v1 = x16_sum(v1); v1 = x32_sum(v1);
            const int m = m0 + r * NGW;
            const float rs = frsq(ss_get(ss, m) * (1.0f / 1024.0f) + EPS);
            if (lane < 8) { const int j = (lane & 1) * 4 + ((lane >> 1) & 1) * 2 + ((lane >> 2) & 1);
                float v = v1 * rs + gbias[j];
                if (j >= 4) v = fminf(v, 0.f) - log1pf(expf(-fabsf(v)));
                GATES[(size_t)m * 8 + j] = v; }
        }
    }
    __syncthreads();
}

DI float silu(float y) { return y * frcp(1.0f + __expf(-y)); }
DI f32x16 mfma32(bf16x8 a, bf16x8 b, f32x16 c) { return __builtin_amdgcn_mfma_f32_32x32x16_bf16(a, b, c, 0, 0, 0); }

DI void conv2(const u32x4 (&x)[5], const LAS float* cw, int dd, float (&y0)[8], float (&y1)[8]) {
    float xf[5][8];
#pragma unroll
    for (int r = 0; r < 5; ++r) { xf[r][0] = bflo(x[r].x); xf[r][1] = bfhi(x[r].x); xf[r][2] = bflo(x[r].y); xf[r][3] = bfhi(x[r].y); xf[r][4] = bflo(x[r].z); xf[r][5] = bfhi(x[r].z); xf[r][6] = bflo(x[r].w); xf[r][7] = bfhi(x[r].w); }
#pragma unroll
    for (int j = 0; j < 8; ++j) { const float b = cw[4 * 128 + dd + j]; float a0 = b, a1 = b;
#pragma unroll
        for (int tp = 0; tp < 4; ++tp) { const float c = cw[tp * 128 + dd + j]; a0 += xf[tp][j] * c; a1 += xf[tp + 1][j] * c; }
        y0[j] = silu(a0); y1[j] = silu(a1); }
}

template <bool P2>
DI void ml_pass(LAS unsigned char* lds, const bf16_t* PROJ, const float* GATES, float* STATE, float* SC, bf16_t* YM,
                const float* convw, const float* convb, const float* ogain, int G, int bid) {
    const int tid = opaque_tid(), lane = tid & 63, w = tid >> 6, l31 = lane & 31, hi = lane >> 5;
    LAS bf16_t* Qs = (LAS bf16_t*)lds;
    LAS bf16_t* Ks = (LAS bf16_t*)(lds + 17408);
    LAS bf16_t* Kt = (LAS bf16_t*)(lds + 34816);
    LAS bf16_t* Vt = (LAS bf16_t*)(lds + 53248);
    LAS bf16_t* Ws = (LAS bf16_t*)(lds + 90112);
    LAS bf16_t* OUTs = (LAS bf16_t*)(lds + 99328);
    LAS float* ns = (LAS float*)(lds + 133120);
    LAS float* gs = (LAS float*)(lds + 133632);
    LAS float* dq = (LAS float*)(lds + 133888);
    LAS float* denp = (LAS float*)(lds + 134144);
    LAS float* ssq = (LAS float*)(lds + 134656);
    LAS float* cw = (LAS float*)(lds + 136704);
    LAS unsigned* Kt32 = (LAS unsigned*)Kt; LAS unsigned* Vt32 = (LAS unsigned*)Vt;
    for (int uid = bid; uid < 256; uid += G) {
        const int b = uid >> 6, h = (uid >> 4) & 3, sg = uid & 15;
        lbar();
        for (int idx = tid; idx < 1280; idx += 512) { const int qk = idx / 640, r = idx % 640, tp = r >> 7, dd = r & 127, ch = qk * 512 + 128 * h + dd;
            cw[idx] = tp < 4 ? convw[tp * 1024 + ch] : convb[ch]; }
        f32x16 Ct[4]; float m_prev = 0.f, gtot = 0.f;
        float* st = STATE + (size_t)uid * ST_STRIDE;
        if (P2) {
#pragma unroll
            for (int dt = 0; dt < 4; ++dt)
#pragma unroll
                for (int i = 0; i < 16; ++i) Ct[dt][i] = st[((w * 4 + dt) * 16 + i) * 64 + lane];
            if (tid < 128) ns[tid] = st[32768 + tid];
            for (int s2 = 0; s2 < sg; ++s2) { const float ml = SC[(uid - sg + s2) * 2], gsg = SC[(uid - sg + s2) * 2 + 1]; m_prev = fmaxf(gsg + m_prev, ml); }
        } else {
#pragma unroll
            for (int dt = 0; dt < 4; ++dt)
#pragma unroll
                for (int i = 0; i < 16; ++i) Ct[dt][i] = 0.f;
            if (tid < 128) ns[tid] = 0.f;
        }
        lbar();
#pragma unroll 1
        for (int c = 0; c < 8; ++c) {
            int tid_o = tid; asm volatile("" : "+v"(tid_o));
            const int tid = tid_o, lane = tid & 63, w = __builtin_amdgcn_readfirstlane(tid >> 6), l31 = lane & 31, hi = lane >> 5;
            const int t0 = sg * 512 + c * 64; const size_t row0 = (size_t)b * 8192 + t0;
            const float li = GATES[(row0 + lane) * 8 + h], lf = GATES[(row0 + lane) * 8 + 4 + h];
            const float bcum = wave_scan_sum(lf);
            const float gq = li - bcum; const float pm = wave_scan_max(gq);
            const float b_last = __builtin_bit_cast(float, __builtin_amdgcn_readlane(__builtin_bit_cast(int, bcum), 63)), pm63 = __builtin_bit_cast(float, __builtin_amdgcn_readlane(__builtin_bit_cast(int, pm), 63));
            const float m_new = fmaxf(b_last + m_prev, b_last + pm63);
            const float decay = __expf(b_last + m_prev - m_new);
            const float wk = __expf(b_last + gq - m_new);
            const float mt = fmaxf(bcum + m_prev, bcum + pm);
            const float inter = __expf(bcum + m_prev - mt);
            if (w == 0) gs[lane] = gq;
            const int sp = tid & 31, pc = tid >> 5;
            {
                u32x4 xr[5];
                const bf16_t* kb = PROJ + (row0 + 2 * sp) * 3072 + 512 + 128 * h + 8 * pc;
#pragma unroll
                for (int r = 0; r < 5; ++r) { const int tt = t0 + 2 * sp - 3 + r; xr[r] = (tt >= 0) ? *(const u32x4*)(kb + ((long)r - 3) * 3072) : (u32x4){0u, 0u, 0u, 0u}; }
                float y0[8], y1[8]; conv2(xr, cw + 640, 8 * pc, y0, y1);
                if (P2) { u32x4 o; o.x = pk2(y0[0], y0[1]); o.y = pk2(y0[2], y0[3]); o.z = pk2(y0[4], y0[5]); o.w = pk2(y0[6], y0[7]); *(LAS u32x4*)(Ks + (2 * sp) * 136 + 8 * pc) = o;
                    o.x = pk2(y1[0], y1[1]); o.y = pk2(y1[2], y1[3]); o.z = pk2(y1[4], y1[5]); o.w = pk2(y1[6], y1[7]); *(LAS u32x4*)(Ks + (2 * sp + 1) * 136 + 8 * pc) = o; }
                const float wk0 = __shfl(wk, 2 * sp), wk1 = __shfl(wk, 2 * sp + 1);
#pragma unroll
                for (int j = 0; j < 8; ++j) Kt32[(8 * pc + j) * 36 + sp] = pk2(y0[j] * wk0, y1[j] * wk1);
                asm volatile("" ::: "memory");
                if (P2) {
                    const bf16_t* qb = PROJ + (row0 + 2 * sp) * 3072 + 128 * h + 8 * pc;
#pragma unroll
                    for (int r = 0; r < 5; ++r) { const int tt = t0 + 2 * sp - 3 + r; xr[r] = (tt >= 0) ? *(const u32x4*)(qb + ((long)r - 3) * 3072) : (u32x4){0u, 0u, 0u, 0u}; }
                    conv2(xr, cw, 8 * pc, y0, y1);
                    const float qs = 0.08838834764831845f;
                    u32x4 o; o.x = pk2(y0[0] * qs, y0[1] * qs); o.y = pk2(y0[2] * qs, y0[3] * qs); o.z = pk2(y0[4] * qs, y0[5] * qs); o.w = pk2(y0[6] * qs, y0[7] * qs); *(LAS u32x4*)(Qs + (2 * sp) * 136 + 8 * pc) = o;
                    o.x = pk2(y1[0] * qs, y1[1] * qs); o.y = pk2(y1[2] * qs, y1[3] * qs); o.z = pk2(y1[4] * qs, y1[5] * qs); o.w = pk2(y1[6] * qs, y1[7] * qs); *(LAS u32x4*)(Qs + (2 * sp + 1) * 136 + 8 * pc) = o;
                }
            }
            asm volatile("" ::: "memory");
#pragma unroll 1
            for (int it = 0; it < 2; ++it) { const int idx = tid + 512 * it, sp2 = idx & 31, pc2 = idx >> 5;
                const bf16_t* vb = PROJ + (row0 + 2 * sp2) * 3072 + 1024 + 256 * h + 8 * pc2;
                const u32x4 r0 = *(const u32x4*)vb, r1 = *(const u32x4*)(vb + 3072);
                LAS unsigned* dst = Vt32 + (8 * pc2) * 36 + sp2;
                dst[0 * 36] = (r0.x & 0xffffu) | (r1.x << 16); dst[1 * 36] = (r0.x >> 16) | (r1.x & 0xffff0000u);
                dst[2 * 36] = (r0.y & 0xffffu) | (r1.y << 16); dst[3 * 36] = (r0.y >> 16) | (r1.y & 0xffff0000u);
                dst[4 * 36] = (r0.z & 0xffffu) | (r1.z << 16); dst[5 * 36] = (r0.z >> 16) | (r1.z & 0xffff0000u);
                dst[6 * 36] = (r0.w & 0xffffu) | (r1.w << 16); dst[7 * 36] = (r0.w >> 16) | (r1.w & 0xffff0000u); }
            lbar();
            if (P2) {
                if (w < 4) {
                    const int stl = w & 1, ttl = w >> 1; const int t = 32 * ttl + l31;
                    float rowsum = 0.f;
                    if (w == 1) {
#pragma unroll
                        for (int i4 = 0; i4 < 4; ++i4) *(LAS u32x2*)(Ws + t * 72 + 32 + 8 * i4 + 4 * hi) = (u32x2){0u, 0u};
                    } else {
                        f32x16 acc;
#pragma unroll
                        for (int i = 0; i < 16; ++i) acc[i] = 0.f;
#pragma unroll
                        for (int kq = 0; kq < 8; ++kq) { const bf16x8 a = *(const LAS bf16x8*)(Ks + (32 * stl + l31) * 136 + 16 * kq + 8 * hi), bb = *(const LAS bf16x8*)(Qs + t * 136 + 16 * kq + 8 * hi);
                            acc = mfma32(a, bb, acc); }
                        const float bc_t = __shfl(bcum, t), mt_t = __shfl(mt, t);
#pragma unroll
                        for (int i4 = 0; i4 < 4; ++i4) { const int s0 = 32 * stl + 8 * i4 + 4 * hi; const f32x4 g4 = *(const LAS f32x4*)(gs + s0); float v[4];
#pragma unroll
                            for (int e = 0; e < 4; ++e) { const int s = s0 + e; v[e] = (s <= t) ? acc[4 * i4 + e] * __expf(bc_t + g4[e] - mt_t) : 0.f; rowsum += v[e]; }
                            u32x2 o; o.x = pk2(v[0], v[1]); o.y = pk2(v[2], v[3]); *(LAS u32x2*)(Ws + t * 72 + s0) = o; }
                    }
                    rowsum = x32_sum(rowsum);
                    if (hi == 0) denp[stl * 64 + t] = rowsum;
                } else {
                    const int t2 = (tid - 256) >> 2, qtr = tid & 3; float s = 0.f;
#pragma unroll
                    for (int q8 = 0; q8 < 4; ++q8) { const int d0 = 32 * qtr + 8 * q8; const u32x4 qv = *(const LAS u32x4*)(Qs + t2 * 136 + d0); const f32x4 n0 = *(const LAS f32x4*)(ns + d0), n1 = *(const LAS f32x4*)(ns + d0 + 4);
                        s += bflo(qv.x) * n0[0] + bfhi(qv.x) * n0[1] + bflo(qv.y) * n0[2] + bfhi(qv.y) * n0[3] + bflo(qv.z) * n1[0] + bfhi(qv.z) * n1[1] + bflo(qv.w) * n1[2] + bfhi(qv.w) * n1[3]; }
                    s += lane_xor1(s); s += lane_xor2(s);
                    if (qtr == 0) dq[t2] = s;
                }
                lbar();
            }
            f32x16 oacc[2];
            if (P2) {
#pragma unroll
                for (int i = 0; i < 16; ++i) { oacc[0][i] = 0.f; oacc[1][i] = 0.f; }
#pragma unroll
                for (int dt = 0; dt < 4; ++dt)
#pragma unroll
                    for (int kq = 0; kq < 2; ++kq) {
                        u32x4 aw; aw.x = pk2(Ct[dt][8 * kq + 0], Ct[dt][8 * kq + 1]); aw.y = pk2(Ct[dt][8 * kq + 2], Ct[dt][8 * kq + 3]); aw.z = pk2(Ct[dt][8 * kq + 4], Ct[dt][8 * kq + 5]); aw.w = pk2(Ct[dt][8 * kq + 6], Ct[dt][8 * kq + 7]);
                        const bf16x8 a = __builtin_bit_cast(bf16x8, aw);
#pragma unroll
                        for (int tt = 0; tt < 2; ++tt) { const LAS bf16_t* qr = Qs + (32 * tt + l31) * 136 + 32 * dt + 16 * kq + 4 * hi;
                            const u32x2 lo = *(const LAS u32x2*)qr, hv = *(const LAS u32x2*)(qr + 8); u32x4 bw; bw.x = lo.x; bw.y = lo.y; bw.z = hv.x; bw.w = hv.y;
                            oacc[tt] = mfma32(a, __builtin_bit_cast(bf16x8, bw), oacc[tt]); }
                    }
#pragma unroll
                for (int tt = 0; tt < 2; ++tt) { const float itv = __shfl(inter, 32 * tt + l31);
#pragma unroll
                    for (int i = 0; i < 16; ++i) oacc[tt][i] *= itv; }
            }
            asm volatile("" ::: "memory");
            bf16x8 vf[4];
#pragma unroll
            for (int kq = 0; kq < 4; ++kq) vf[kq] = *(const LAS bf16x8*)(Vt + (32 * w + l31) * 72 + 16 * kq + 8 * hi);
            if (P2) {
#pragma unroll
                for (int kq = 0; kq < 4; ++kq)
#pragma unroll
                    for (int tt = 0; tt < 2; ++tt) { const bf16x8 wf = *(const LAS bf16x8*)(Ws + (32 * tt + l31) * 72 + 16 * kq + 8 * hi); oacc[tt] = mfma32(vf[kq], wf, oacc[tt]); }
            }
            asm volatile("" ::: "memory");
            if (!P2 || c < 7) {
#pragma unroll
            for (int dt = 0; dt < 4; ++dt) {
#pragma unroll
                for (int i = 0; i < 16; ++i) Ct[dt][i] *= decay;
#pragma unroll
                for (int kq = 0; kq < 4; ++kq) { const bf16x8 kf = *(const LAS bf16x8*)(Kt + (32 * dt + l31) * 72 + 16 * kq + 8 * hi); Ct[dt] = mfma32(kf, vf[kq], Ct[dt]); }
            }
            }
            asm volatile("" ::: "memory");
            if (tid < 128) { float s = 0.f;
#pragma unroll
                for (int q8 = 0; q8 < 8; ++q8) { const u32x4 kv = *(const LAS u32x4*)(Kt + tid * 72 + 8 * q8); s += (bflo(kv.x) + bfhi(kv.x)) + (bflo(kv.y) + bfhi(kv.y)) + (bflo(kv.z) + bfhi(kv.z)) + (bflo(kv.w) + bfhi(kv.w)); }
                ns[tid] = decay * ns[tid] + s; }
            if (P2) {
#pragma unroll
                for (int tt = 0; tt < 2; ++tt) { const int t = 32 * tt + l31; const float itv = __shfl(inter, t), mt_t = __shfl(mt, t);
                    const float den = itv * dq[t] + denp[t] + denp[64 + t];
                    const float rd = frcp(fmaxf(fabsf(den), __expf(-mt_t))); float sq = 0.f;
#pragma unroll
                    for (int i4 = 0; i4 < 4; ++i4) { float v[4];
#pragma unroll
                        for (int e = 0; e < 4; ++e) { v[e] = oacc[tt][4 * i4 + e] * rd; sq += v[e] * v[e]; }
                        u32x2 o; o.x = pk2(v[0], v[1]); o.y = pk2(v[2], v[3]); *(LAS u32x2*)(OUTs + t * 264 + 32 * w + 8 * i4 + 4 * hi) = o; }
                    sq = x32_sum(sq);
                    if (hi == 0) ssq[w * 64 + t] = sq; }
            }
            lbar();
            if (P2) {
#pragma unroll
                for (int it = 0; it < 4; ++it) { const int idx = tid + 512 * it, t = idx >> 5, pc3 = idx & 31;
                    float ssum = 0.f;
#pragma unroll
                    for (int ww = 0; ww < 8; ++ww) ssum += ssq[ww * 64 + t];
                    const float rstd = frsq(ssum * (1.0f / 256.0f) + EPS);
                    const u32x4 hv = *(const LAS u32x4*)(OUTs + t * 264 + 8 * pc3);
                    const u32x4 op = *(const u32x4*)(PROJ + (row0 + t) * 3072 + 2048 + 256 * h + 8 * pc3);
                    const f32x4 g0 = *(const f32x4*)(ogain + h * 256 + 8 * pc3), g1 = *(const f32x4*)(ogain + h * 256 + 8 * pc3 + 4);
                    float hvf[8] = {bflo(hv.x), bfhi(hv.x), bflo(hv.y), bfhi(hv.y), bflo(hv.z), bfhi(hv.z), bflo(hv.w), bfhi(hv.w)};
                    float opf[8] = {bflo(op.x), bfhi(op.x), bflo(op.y), bfhi(op.y), bflo(op.z), bfhi(op.z), bflo(op.w), bfhi(op.w)};
                    float y[8];
#pragma unroll
                    for (int j = 0; j < 8; ++j) y[j] = hvf[j] * rstd * (j < 4 ? g0[j & 3] : g1[j & 3]) * opf[j];
                    u32x4 o; o.x = pk2(y[0], y[1]); o.y = pk2(y[2], y[3]); o.z = pk2(y[4], y[5]); o.w = pk2(y[6], y[7]);
                    *(u32x4*)(YM + (row0 + t) * 1024 + 256 * h + 8 * pc3) = o; }
            }
            m_prev = m_new; gtot += b_last;
        }
        if (!P2) {
#pragma unroll
            for (int dt = 0; dt < 4; ++dt)
#pragma unroll
                for (int i = 0; i < 16; ++i) st[((w * 4 + dt) * 16 + i) * 64 + lane] = Ct[dt][i];
            lbar();
            if (tid < 128) st[32768 + tid] = ns[tid];
            if (tid == 0) { SC[uid * 2] = m_prev; SC[uid * 2 + 1] = gtot; }
        }
    }
}

DI void scan_phase(float* STATE, const float* SC, int G, int bid) {
    const int total = 16 * ST_STRIDE;
    for (int el = bid * 512 + opaque_tid(); el < total; el += G * 512) {
        const int bh = el / ST_STRIDE, e = el % ST_STRIDE; float cur = 0.f, mcur = 0.f;
#pragma unroll
        for (int s2 = 0; s2 < 16; ++s2) { const int uid = bh * 16 + s2; float* p = STATE + (size_t)uid * ST_STRIDE + e; const float l = *p; *p = cur;
            const float ml = SC[uid * 2], gsg = SC[uid * 2 + 1]; const float mo = fmaxf(gsg + mcur, ml);
            cur = __expf(gsg + mcur - mo) * cur + __expf(ml - mo) * l; mcur = mo; }
    }
}

#define XB_TMO      128
#define XB_XCNT(j)  (256  + 64 * (j))
#define XB_XSUB(j)  (1280 + 64 * (j))
#define XB_XGEN(j)  (2304 + 64 * (j))
#define XB_TOP      3328
#define XB_TOPGEN   3392
#define XCD_BAR_WORDS 3456
#define XB_SPIN_CAP (1u << 18)

__device__ __forceinline__ unsigned xb_ld(unsigned* p)              { return __hip_atomic_load(p, __ATOMIC_RELAXED, __HIP_MEMORY_SCOPE_AGENT); }
__device__ __forceinline__ unsigned xb_add(unsigned* p, unsigned v) { return __hip_atomic_fetch_add(p, v, __ATOMIC_RELAXED, __HIP_MEMORY_SCOPE_AGENT); }
__device__ __forceinline__ unsigned xb_xcc_id() { return (unsigned)__builtin_amdgcn_s_getreg((3 << 11) | 20) & 0xFu; }
#define XB_SPIN(cond, bar) do { unsigned _sp = 0; while (cond) { __builtin_amdgcn_s_sleep(1); \
    if ((++_sp & 255u) == 0u) { if (xb_ld(&(bar)[XB_TMO])) break; if (_sp > XB_SPIN_CAP) { atomicAdd(&(bar)[XB_TMO], 1u); break; } } } } while (0)

struct XcdBarrier {
    unsigned* bar; unsigned x;
    volatile LAS unsigned* st;
};

__device__ __forceinline__ XcdBarrier xcd_barrier_post(unsigned* bar, volatile LAS unsigned* st) {
    XcdBarrier b; b.bar = bar; b.x = xb_xcc_id(); b.st = st;
    if (threadIdx.x == 0) (void)xb_add(&bar[XB_XCNT(b.x)], 1u);
    return b;
}
__device__ __forceinline__ void xcd_barrier_complete(unsigned* bar, unsigned x, unsigned& nloc, unsigned& nx) {
    const unsigned G = gridDim.x * gridDim.y * gridDim.z;
    unsigned sum, cnt, mine, sp = 0u;
    for (;;) {
        sum = 0u; cnt = 0u; mine = 0u;
#pragma unroll
        for (unsigned j = 0; j < 16; ++j) { const unsigned c = xb_ld(&bar[XB_XCNT(j)]); sum += c; cnt += (c > 0u) ? 1u : 0u; mine = (j == x) ? c : mine; }
        if (sum == G) break;
        __builtin_amdgcn_s_sleep(1);
        if ((++sp & 255u) == 0u) { if (xb_ld(&bar[XB_TMO])) break; if (sp > XB_SPIN_CAP) { atomicAdd(&bar[XB_TMO], 1u); break; } }
    }
    nloc = mine > 0u ? mine : 1u; nx = cnt > 0u ? cnt : 1u;
}

__device__ __forceinline__ void xcd_barrier(const XcdBarrier& b) {
    asm volatile("s_waitcnt vmcnt(0)" ::: "memory");
    __syncthreads();
    if (threadIdx.x == 0) {
        unsigned* bar = b.bar;
        __builtin_amdgcn_s_waitcnt(0);
        unsigned nloc = b.st[0], nx = b.st[1];
        if (nloc == 0u) { xcd_barrier_complete(bar, b.x, nloc, nx); b.st[0] = nloc; b.st[1] = nx; }
        const unsigned old = xb_add(&bar[XB_XSUB(b.x)], 1u);
        const unsigned gen = old / nloc;
        if (old + 1u == (gen + 1u) * nloc) {
            __builtin_amdgcn_fence(__ATOMIC_RELEASE, "agent");
            asm volatile("s_waitcnt vmcnt(0)" ::: "memory");
            const unsigned og = xb_add(&bar[XB_TOP], 1u);
            const unsigned tg = og / nx;
            if (og + 1u == (tg + 1u) * nx) xb_add(&bar[XB_TOPGEN], 1u);
            else XB_SPIN(xb_ld(&bar[XB_TOPGEN]) == tg, bar);
            __builtin_amdgcn_fence(__ATOMIC_ACQUIRE, "agent");
            xb_add(&bar[XB_XGEN(b.x)], 1u);
            asm volatile("s_waitcnt vmcnt(0)" ::: "memory");
        } else {
            XB_SPIN(xb_ld(&bar[XB_XGEN(b.x)]) == gen, bar);
            __builtin_amdgcn_fence(__ATOMIC_ACQUIRE, "agent");
            asm volatile("s_waitcnt vmcnt(0)" ::: "memory");
        }
    }
    __syncthreads();
}

enum { PT_PRO = 0, PT_QKV, PT_ATTN, PT_MERGE, PT_AOUT, PT_UP, PT_DOWN, PT_MIN, PT_P1, PT_SCAN, PT_P2, PT_MOUT };
DI void decode_phase(int ph, int& type, int& layer, int& half) {
    half = 0;
    if (ph == 0) { type = PT_PRO; layer = 0; return; }
    int p = ph - 1; layer = 0;
    for (;;) { const int len = (layer & 1) ? 7 : 10; if (p < len) break; p -= len; ++layer; }
    if (layer & 1) { type = (p == 0) ? PT_MIN : (p == 1) ? PT_P1 : (p == 2) ? PT_SCAN : (p == 3) ? PT_P2 : (p == 4) ? PT_MOUT : (p == 5) ? PT_UP : PT_DOWN; }
    else { if (p < 8) { half = p >> 2; const int q = p & 3; type = (q == 0) ? PT_QKV : (q == 1) ? PT_ATTN : (q == 2) ? PT_MERGE : PT_AOUT; } else type = (p == 8) ? PT_UP : PT_DOWN; }
}

__global__ void __launch_bounds__(512, 2) mega(Args a) {
    extern __shared__ __attribute__((aligned(16))) unsigned char lds_raw[];
    LAS unsigned char* lds = (LAS unsigned char*)lds_raw;
    const int G = gridDim.x, bid = blockIdx.x;
    unsigned char* ws = a.ws;
    ss_t* ssb = (ss_t*)(ws + WS_SS);
    bf16_t* XB = (bf16_t*)(ws + WS_XB);
    unsigned char* R = ws + WS_R;
    volatile LAS unsigned* MISC = (volatile LAS unsigned*)(lds + 147200);
    if (threadIdx.x < 2) MISC[threadIdx.x] = 0u;
    __syncthreads();
    XcdBarrier bar = xcd_barrier_post((unsigned*)ws, MISC);
#pragma unroll 1
    for (int ph = a.ph_lo; ph < a.ph_hi; ++ph) {
        if (ph > a.ph_lo) { if (a.ph_hi > 1000) cg::this_grid().sync();   else xcd_barrier(bar); }
        int type, L, half; decode_phase(ph, type, L, half);
        const int j = L >> 1;
        if (type == PT_PRO) { prologue(a, lds, G, bid); }
        else if (type == PT_QKV || type == PT_MIN || type == PT_UP) {
            pg8::Gemm g; pg8::EpiScale E;
            if (type == PT_QKV) { g = pg8::Gemm{XB + (size_t)half * TH * 1024, (const bf16_t*)(ws + W_AIN + (size_t)j * 18 * MiB), TH, 9216, 1024}; E = pg8::EpiScale{(bf16_t*)R, 1024, ssb + (size_t)(2 * L) * T_ALL + half * TH, 0, a.in[5] + j * 192, a.in[6] + j * 192}; }
            else if (type == PT_MIN) { g = pg8::Gemm{XB, (const bf16_t*)(ws + W_MIN + (size_t)j * 6 * MiB), T_ALL, 3072, 1024}; E = pg8::EpiScale{(bf16_t*)R, 3072, ssb + (size_t)(2 * L) * T_ALL, 1, nullptr, nullptr}; }
            else { g = pg8::Gemm{XB, (const bf16_t*)(ws + W_UP + (size_t)L * 8 * MiB), T_ALL, 4096, 1024}; E = pg8::EpiScale{(bf16_t*)R, 4096, ssb + (size_t)(2 * L + 1) * T_ALL, 2, nullptr, nullptr}; }
            pg8::StaticOrder S; S.init(g.M, g.N, G, bid);
            pg8::gemm_phase<pg8::EpiScale, pg8::StaticOrder, true, true>(lds, g, S, E);
            if (type == PT_MIN) gates_phase(lds, XB, ssb + (size_t)(2 * L) * T_ALL, a.in[8] + (size_t)j * 1024 * 3080, a.in[1] + (size_t)L * 1024, a.in[9] + j * 8, (float*)(R + R_GATES), G, bid);
        }
        else if (type == PT_AOUT || type == PT_MOUT || type == PT_DOWN) {
            pg8::Gemm g; pg8::EpiRes E;
            if (type == PT_AOUT) { g = pg8::Gemm{(const bf16_t*)R, (const bf16_t*)(ws + W_AOUT + (size_t)j * 2 * MiB), TH, 1024, 1024}; E = pg8::EpiRes{nullptr, XB, ssb + (size_t)(2 * L + 1) * T_ALL, half * TH}; }
            else if (type == PT_MOUT) { g = pg8::Gemm{(const bf16_t*)(R + R_YM), (const bf16_t*)(ws + W_MOUT + (size_t)j * 2 * MiB), T_ALL, 1024, 1024}; E = pg8::EpiRes{nullptr, XB, ssb + (size_t)(2 * L + 1) * T_ALL, 0}; }
            else { g = pg8::Gemm{(const bf16_t*)R, (const bf16_t*)(ws + W_DN + (size_t)L * 8 * MiB), T_ALL, 1024, 4096}; E = pg8::EpiRes{(L == 3) ? a.out : nullptr, XB, (L < 3) ? ssb + (size_t)(2 * L + 2) * T_ALL : nullptr, 0}; }
            pg8::StaticOrder S; S.init(g.M, g.N, G, bid);
            pg8::gemm_phase<pg8::EpiRes, pg8::StaticOrder, true, true>(lds, g, S, E);
        }
        else if (type == PT_ATTN) { attn_phase(lds, (bf16_t*)R, (float*)(R + R_LSE), a.in[5] + j * 192, a.in[6] + j * 192, a.in[3], G, bid); }
        else if (type == PT_MERGE) { merge_phase((bf16_t*)R, (const float*)(R + R_LSE), G, bid); }
        else if (type == PT_P1) { ml_pass<false>(lds, (const bf16_t*)R, (const float*)(R + R_GATES), (float*)(R + R_STATE), (float*)(R + R_SC), (bf16_t*)(R + R_YM), a.in[10] + (size_t)j * 4096, a.in[11] + (size_t)j * 1024, a.in[12] + (size_t)j * 1024, G, bid); }
        else if (type == PT_SCAN) { scan_phase((float*)(R + R_STATE), (const float*)(R + R_SC), G, bid); }
        else if (type == PT_P2) { ml_pass<true>(lds, (const bf16_t*)R, (const float*)(R + R_GATES), (float*)(R + R_STATE), (float*)(R + R_SC), (bf16_t*)(R + R_YM), a.in[10] + (size_t)j * 4096, a.in[11] + (size_t)j * 1024, a.in[12] + (size_t)j * 1024, G, bid); }
    }
}

#ifndef MK_ONE_LAUNCH
#define MK_ONE_LAUNCH 1
#endif
extern "C" void kernel_launch(void* const* d_in, const int* in_sizes, int n_in, void* d_out, int out_size, void* d_ws, size_t ws_size, hipStream_t stream) {
    static int grid = 0;
    if (grid == 0) {
        if (n_in != 16 || out_size != T_ALL * DM || ws_size < WS_NEED) { fprintf(stderr, "kernel_launch: unexpected shapes / workspace %zu\n", ws_size); grid = -1; return; }
        int dev = 0, cus = 0, per_cu = 0;
        hipGetDevice(&dev); hipDeviceGetAttribute(&cus, hipDeviceAttributeMultiprocessorCount, dev);
        hipFuncSetAttribute((const void*)mega, hipFuncAttributeMaxDynamicSharedMemorySize, LDS_BYTES);
        hipOccupancyMaxActiveBlocksPerMultiprocessor(&per_cu, (const void*)mega, 512, LDS_BYTES);
        (void)hipGetLastError();
        if (per_cu < 1) per_cu = 1;
        grid = cus * 1;
        if (grid <= 0) grid = 256;
    }
    if (grid < 0) return;
    Args a{};
    for (int i = 0; i < 16; ++i) a.in[i] = (const float*)d_in[i];
    a.out = (float*)d_out; a.ws = (unsigned char*)d_ws;
#if MK_ONE_LAUNCH
    (void)hipMemsetAsync(d_ws, 0, 16384, stream);
    a.ph_lo = 0; a.ph_hi = NPH;
    void* args[] = {&a};
    hipError_t e = hipLaunchCooperativeKernel((const void*)mega, dim3(grid), dim3(512), args, LDS_BYTES, stream);
    if (e != hipSuccess) fprintf(stderr, "cooperative launch failed: %s\n", hipGetErrorString(e));
#else
    for (int ph = 0; ph < DBG_NPH; ++ph) { a.ph_lo = ph; a.ph_hi = ph + 1; hipLaunchKernelGGL(mega, dim3(grid), dim3(512), LDS_BYTES, stream, a); }
#endif
}
```

```cpp
#include <hip/hip_runtime.h>
#include <cstdio>
#include <cstdint>
#include <cmath>
__device__ __forceinline__ int opaque_tid() { int t = threadIdx.x; asm volatile("" : "+v"(t)); return t; }
namespace pg8 {
#define PG8_LAS __attribute__((address_space(3)))
typedef unsigned short bf16_t;
typedef short bf16x8 __attribute__((ext_vector_type(8)));
typedef float f32x4 __attribute__((ext_vector_type(4)));
typedef unsigned u32x4 __attribute__((ext_vector_type(4)));
constexpr int BM = 256, BK = 64, HALF = 128, HTB = HALF * BK * 2  , STAGE_BYTES = 8 * HTB, NXCD = 8, WGM = 8;

__host__ __device__ __forceinline__ int lds_byte(int r, int c) { const int st = (r >> 4) * 2 + (c >> 5), rr = r & 15, cc = c & 31, ob = rr * 64 + cc * 2; return st * 1024 + (ob ^ (((ob >> 9) & 1) << 5)); }
__host__ __device__ __forceinline__ void stage_rc(int b, int& R, int& C) { const int st = b / 1024, sb = b % 1024, swz = sb ^ (((sb >> 9) & 1) << 5); R = (st >> 1) * 16 + swz / 64; C = (st & 1) * 32 + (swz % 64) / 2; }
__host__ __device__ __forceinline__ int perm32(int rho) { const int n = rho >> 4, i = rho & 15; return 8 * (i >> 2) + 4 * n + (i & 3); }

struct Unit { int pm, pn; };
struct Gemm { const bf16_t* A; const bf16_t* Bt; int M, N, K; };

struct StaticOrder {
    int nM, nN, nwg, G, c;
    __host__ __device__ void init(int M, int N, int G_, int c_) { nM = M / BM; nN = N / BM; nwg = nM * nN; G = G_; c = c_; }
    __host__ __device__ bool next(int i, Unit& u) const {
        const long L = (long)i * G + c; if (L >= nwg) return false;
        int wgid = (int)L; { const int q = nwg / NXCD, r = nwg % NXCD, xcd = wgid % NXCD, off = wgid / NXCD; wgid = (xcd < r ? xcd * (q + 1) : r * (q + 1) + (xcd - r) * q) + off; }
        const int nig = WGM * nN, gid = wgid / nig, fm = gid * WGM, gsz = (nM - fm) < WGM ? (nM - fm) : WGM;
        u.pm = fm + ((wgid % nig) % gsz); u.pn = (wgid % nig) / gsz; return true;
    }
    __device__ __forceinline__ void a_ready(const Unit&) const {}
    __device__ __forceinline__ void done(const Unit&) const {}
};

__device__ __forceinline__ unsigned cvt_pk_bf16(float lo, float hi) { unsigned r; asm volatile("v_cvt_pk_bf16_f32 %0, %1, %2" : "=v"(r) : "v"(lo), "v"(hi)); return r; }
template <class Epi, class Sched, bool ALIGN_EPI = false, bool SP2 = false>
__device__ __forceinline__ void gemm_phase(PG8_LAS unsigned char* lds, const Gemm g, const Sched& S, const Epi& E) {
    const int tid = opaque_tid(), wid = __builtin_amdgcn_readfirstlane(tid >> 6), lane = tid & 63, wr = wid >> 2, wc = wid & 3, fr = lane & 15, fq = lane >> 4;
    const int K = g.K, nt = K / BK;
    unsigned voffA[2], voffB[2];
#pragma unroll
    for (int i = 0; i < 2; ++i) { int R, C; stage_rc(tid * 16 + i * 8192, R, C); const int Rb = Epi::PERM ? ((R & ~31) + perm32(R & 31)) : R;
        voffA[i] = (unsigned)(R * K + C) * 2u; voffB[i] = (unsigned)(Rb * K + C) * 2u; }
    const size_t kstep = (size_t)(BK * 2);
    const size_t hstep = (size_t)HALF * K * 2;
    const size_t tstep = 2 * hstep;
    const unsigned ldsw = (unsigned)wid * 1024u;
    const int aoff = lds_byte(wr * 64 + fr, fq * 8), boff = lds_byte(wc * 32 + fr, fq * 8);
#define PG8_SA(b, h) (((b) * 2 + (h)) * HTB)
#define PG8_SB(b, h) ((4 + (b) * 2 + (h)) * HTB)
#define PG8_STAGE(bufoff, gbase, voff) do { _Pragma("unroll") for (int _i = 0; _i < 2; ++_i) \
        __builtin_amdgcn_global_load_lds((const unsigned*)((const char*)(gbase) + (voff)[_i]), (PG8_LAS unsigned*)(lds + (bufoff) + ldsw + _i * 8192), 16, 0, 0); } while (0)
#define PG8_LDA(dst, b, h) do { _Pragma("unroll") for (int m = 0; m < 4; ++m) _Pragma("unroll") for (int k = 0; k < 2; ++k) dst[m][k] = *(const PG8_LAS bf16x8*)(lds + PG8_SA(b, h) + aoff + m * 2048 + k * 1024); } while (0)
#define PG8_LDB(dst, b, h) do { _Pragma("unroll") for (int n = 0; n < 2; ++n) _Pragma("unroll") for (int k = 0; k < 2; ++k) dst[n][k] = *(const PG8_LAS bf16x8*)(lds + PG8_SB(b, h) + boff + n * 2048 + k * 1024); } while (0)
#define PG8_MMA(ai, bj, At, Bt) do { __builtin_amdgcn_s_setprio(1); _Pragma("unroll") for (int m = 0; m < 4; ++m) _Pragma("unroll") for (int n = 0; n < 2; ++n) _Pragma("unroll") for (int k = 0; k < 2; ++k) \
        acc[ai][bj][m][n] = __builtin_amdgcn_mfma_f32_16x16x32_bf16(Bt[n][k], At[m][k], acc[ai][bj][m][n], 0, 0, 0); __builtin_amdgcn_s_setprio(0); } while (0)
#define PG8_WAIT_V(n) asm volatile("s_waitcnt vmcnt(" #n ")" ::: "memory")
#define PG8_WAIT_L(n) asm volatile("s_waitcnt lgkmcnt(" #n ")" ::: "memory")
#define PG8_BAR __builtin_amdgcn_s_barrier()
#define PG8_SCHED __builtin_amdgcn_sched_barrier(0)
    Unit cur, nxt; int ui = 0;
    if (!S.next(0, cur)) return;
    f32x4 acc[2][2][4][2];
#pragma unroll
    for (int a = 0; a < 2; ++a)
#pragma unroll
        for (int b = 0; b < 2; ++b)
#pragma unroll
            for (int m = 0; m < 4; ++m)
#pragma unroll
                for (int n = 0; n < 2; ++n) acc[a][b][m][n] = (f32x4){0.f, 0.f, 0.f, 0.f};
    bf16x8 At[4][2], B0[2][2], B1[2][2];
    const char* cA = (const char*)g.A + (size_t)cur.pm * tstep; const char* cB = (const char*)g.Bt + (size_t)cur.pn * tstep;
    S.a_ready(cur);
    if constexpr (SP2) {
        PG8_STAGE(PG8_SB(0, 0), cB, voffB); PG8_STAGE(PG8_SB(0, 1), cB + hstep, voffB); PG8_STAGE(PG8_SA(0, 0), cA, voffA); PG8_STAGE(PG8_SA(0, 1), cA + hstep, voffA);
        if (wr == 1) PG8_BAR;
        PG8_WAIT_V(2); PG8_BAR;
        PG8_STAGE(PG8_SB(1, 0), cB + kstep, voffB); PG8_STAGE(PG8_SA(1, 0), cA + kstep, voffA); PG8_STAGE(PG8_SB(1, 1), cB + hstep + kstep, voffB);
        PG8_WAIT_V(6); PG8_BAR;
    } else {
        PG8_STAGE(PG8_SB(0, 0), cB, voffB); PG8_STAGE(PG8_SA(0, 0), cA, voffA); PG8_STAGE(PG8_SB(0, 1), cB + hstep, voffB); PG8_STAGE(PG8_SA(0, 1), cA + hstep, voffA);
        if (wr == 1) PG8_BAR;
        PG8_WAIT_V(4); PG8_BAR;
        PG8_STAGE(PG8_SB(1, 0), cB + kstep, voffB); PG8_STAGE(PG8_SA(1, 0), cA + kstep, voffA); PG8_STAGE(PG8_SB(1, 1), cB + hstep + kstep, voffB);
        PG8_WAIT_V(6); PG8_BAR;
    }
    for (;;) {
        const bool has_next = S.next(ui + 1, nxt);
        const char* nA = has_next ? (const char*)g.A + (size_t)nxt.pm * tstep : cA; const char* nB = has_next ? (const char*)g.Bt + (size_t)nxt.pn * tstep : cB;
        for (int t = 0; t < nt; t += 2) {
            const bool last = (t == nt - 2);
            const char* a1 = cA + (size_t)(t + 1) * kstep;
            const char* a2 = last ? nA : cA + (size_t)(t + 2) * kstep; const char* b2 = last ? nB : cB + (size_t)(t + 2) * kstep;
            const char* a3 = a2 + kstep; const char* b3 = b2 + kstep;
            if (last && has_next) S.a_ready(nxt);
            if constexpr (SP2) {
            PG8_LDB(B0, 0, 0); PG8_LDB(B1, 0, 1); PG8_SCHED; PG8_LDA(At, 0, 0); PG8_STAGE(PG8_SA(1, 1), a1 + hstep, voffA);
            PG8_WAIT_V(8); PG8_WAIT_L(0); PG8_BAR; PG8_MMA(0, 0, At, B0); PG8_MMA(0, 1, At, B1); PG8_BAR; PG8_SCHED;
            PG8_LDA(At, 0, 1); PG8_STAGE(PG8_SB(0, 0), b2, voffB); PG8_STAGE(PG8_SB(0, 1), b2 + hstep, voffB); PG8_STAGE(PG8_SA(0, 0), a2, voffA);
            PG8_WAIT_V(8); PG8_WAIT_L(0); PG8_BAR; PG8_MMA(1, 0, At, B0); PG8_MMA(1, 1, At, B1); PG8_BAR; PG8_SCHED;
            PG8_LDB(B0, 1, 0); PG8_LDB(B1, 1, 1); PG8_SCHED; PG8_LDA(At, 1, 0); PG8_STAGE(PG8_SA(0, 1), a2 + hstep, voffA);
            PG8_WAIT_V(8); PG8_WAIT_L(0); PG8_BAR; PG8_MMA(0, 0, At, B0); PG8_MMA(0, 1, At, B1); PG8_BAR; PG8_SCHED;
            PG8_LDA(At, 1, 1); PG8_STAGE(PG8_SB(1, 0), b3, voffB); PG8_STAGE(PG8_SB(1, 1), b3 + hstep, voffB); PG8_STAGE(PG8_SA(1, 0), a3, voffA);
            PG8_WAIT_V(8); PG8_WAIT_L(0); PG8_BAR; PG8_MMA(1, 0, At, B0); PG8_MMA(1, 1, At, B1); PG8_BAR; PG8_SCHED;
            } else {
            PG8_LDB(B0, 0, 0); PG8_SCHED; PG8_LDA(At, 0, 0); PG8_STAGE(PG8_SA(1, 1), a1 + hstep, voffA);
            PG8_WAIT_L(8); PG8_BAR; PG8_WAIT_L(0); PG8_MMA(0, 0, At, B0); PG8_BAR; PG8_SCHED;
            PG8_LDB(B1, 0, 1); PG8_STAGE(PG8_SB(0, 0), b2, voffB);
            PG8_BAR; PG8_WAIT_L(0); PG8_MMA(0, 1, At, B1); PG8_BAR;
            PG8_LDA(At, 0, 1); PG8_STAGE(PG8_SA(0, 0), a2, voffA);
            PG8_BAR; PG8_WAIT_L(0); PG8_MMA(1, 0, At, B0); PG8_BAR; PG8_SCHED;
            PG8_STAGE(PG8_SB(0, 1), b2 + hstep, voffB);
            PG8_WAIT_V(6); PG8_BAR; PG8_MMA(1, 1, At, B1); PG8_BAR;
            PG8_LDB(B0, 1, 0); PG8_SCHED; PG8_LDA(At, 1, 0); PG8_STAGE(PG8_SA(0, 1), a2 + hstep, voffA);
            PG8_WAIT_L(8); PG8_BAR; PG8_WAIT_L(0); PG8_MMA(0, 0, At, B0); PG8_BAR; PG8_SCHED;
            PG8_LDB(B1, 1, 1); PG8_STAGE(PG8_SB(1, 0), b3, voffB);
            PG8_BAR; PG8_WAIT_L(0); PG8_MMA(0, 1, At, B1); PG8_BAR;
            PG8_LDA(At, 1, 1); PG8_STAGE(PG8_SA(1, 0), a3, voffA);
            PG8_BAR; PG8_WAIT_L(0); PG8_MMA(1, 0, At, B0); PG8_BAR; PG8_SCHED;
            PG8_STAGE(PG8_SB(1, 1), b3 + hstep, voffB);
            PG8_WAIT_V(6); PG8_BAR; PG8_MMA(1, 1, At, B1); PG8_BAR;
            }
        }
        if constexpr (ALIGN_EPI) { if (wr == 0) PG8_BAR; }
        if constexpr (!Epi::AFTER_DRAIN) { E(acc, cur, wr, wc, fr, fq); S.done(cur); }
        if (!has_next) break;
#pragma unroll
        for (int a = 0; a < 2; ++a)
#pragma unroll
            for (int b = 0; b < 2; ++b)
#pragma unroll
                for (int m = 0; m < 4; ++m)
#pragma unroll
                    for (int n = 0; n < 2; ++n) acc[a][b][m][n] = (f32x4){0.f, 0.f, 0.f, 0.f};
        cur = nxt; cA = nA; cB = nB; ++ui;
        if constexpr (ALIGN_EPI) { if (wr == 1) PG8_BAR; }
    }
    PG8_WAIT_V(0);
    if constexpr (!ALIGN_EPI) { if (wr == 0) PG8_BAR; }
    PG8_BAR;
    if constexpr (Epi::AFTER_DRAIN) { E.fused(acc, cur, wr, wc, fr, fq, lds, wid, lane); S.done(cur); }
#undef PG8_SA
#undef PG8_SB
#undef PG8_STAGE
#undef PG8_LDA
#undef PG8_LDB
#undef PG8_MMA
#undef PG8_WAIT_V
#undef PG8_WAIT_L
#undef PG8_BAR
#undef PG8_SCHED
}
}

#include <hip/hip_cooperative_groups.h>
namespace cg = cooperative_groups;

constexpr int T_ALL = 32768, SEQ = 8192, DM = 1024, TH = 16384;
constexpr float EPS = 1e-6f;
constexpr size_t MiB = 1u << 20;
constexpr size_t WS_SS = (186 + 292) * MiB;
constexpr size_t WS_W = 2 * MiB;
constexpr size_t W_AIN = WS_W, W_AOUT = WS_W + 36 * MiB, W_MIN = WS_W + 40 * MiB, W_MOUT = WS_W + 52 * MiB, W_UP = WS_W + 56 * MiB, W_DN = WS_W + 88 * MiB;
constexpr size_t WS_XB = 122 * MiB;
constexpr size_t WS_R = 186 * MiB;
constexpr size_t SEC = (size_t)TH * DM;
constexpr size_t R_LSE = 288 * MiB;
constexpr size_t R_GATES = 192 * MiB, R_STATE = 193 * MiB, R_SC = 226 * MiB, R_YM = 227 * MiB;
constexpr int ST_STRIDE = 32768 + 128;
constexpr size_t WS_NEED = 512 * MiB;
constexpr int LDS_BYTES = 147456;
constexpr int NPH = 35;
#define DBG_NPH NPH

#define LAS __attribute__((address_space(3)))
#define DI __device__ __forceinline__
typedef unsigned short bf16_t;
typedef short bf16x8 __attribute__((ext_vector_type(8)));
typedef float f32x4 __attribute__((ext_vector_type(4)));
typedef float f32x16 __attribute__((ext_vector_type(16)));
typedef unsigned u32x4 __attribute__((ext_vector_type(4)));
typedef unsigned u32x2 __attribute__((ext_vector_type(2)));

DI unsigned f2bf(float f) { unsigned u = __builtin_bit_cast(unsigned, f); return (u + 0x7fffu + ((u >> 16) & 1u)) >> 16; }
typedef float f32x2n __attribute__((ext_vector_type(2)));
typedef __bf16 bf16x2n __attribute__((ext_vector_type(2)));
DI unsigned pk2(float lo, float hi) { f32x2n v = {lo, hi}; bf16x2n b = __builtin_convertvector(v, bf16x2n); return __builtin_bit_cast(unsigned, b); }
DI float bflo(unsigned w) { return __builtin_bit_cast(float, w << 16); }
DI float bfhi(unsigned w) { return __builtin_bit_cast(float, w & 0xffff0000u); }
DI float wave_sum(float v) {
#pragma unroll
    for (int o = 1; o < 64; o <<= 1) v += __shfl_xor(v, o);
    return v;
}
DI float x16_sum(float x) { const unsigned u = __builtin_bit_cast(unsigned, x); auto r = __builtin_amdgcn_permlane16_swap(u, u, false, false); return __builtin_bit_cast(float, (unsigned)r[0]) + __builtin_bit_cast(float, (unsigned)r[1]); }
DI float x32_sum(float x) { const unsigned u = __builtin_bit_cast(unsigned, x); auto r = __builtin_amdgcn_permlane32_swap(u, u, false, false); return __builtin_bit_cast(float, (unsigned)r[0]) + __builtin_bit_cast(float, (unsigned)r[1]); }
DI float x16_max(float x) { const unsigned u = __builtin_bit_cast(unsigned, x); auto r = __builtin_amdgcn_permlane16_swap(u, u, false, false); return fmaxf(__builtin_bit_cast(float, (unsigned)r[0]), __builtin_bit_cast(float, (unsigned)r[1])); }
DI float x32_max(float x) { const unsigned u = __builtin_bit_cast(unsigned, x); auto r = __builtin_amdgcn_permlane32_swap(u, u, false, false); return fmaxf(__builtin_bit_cast(float, (unsigned)r[0]), __builtin_bit_cast(float, (unsigned)r[1])); }
template <int CTRL, int ROWMASK> DI float dpp_mov(float old, float x) { return __builtin_bit_cast(float, __builtin_amdgcn_update_dpp(__builtin_bit_cast(int, old), __builtin_bit_cast(int, x), CTRL, ROWMASK, 0xf, false)); }
DI float wave_scan_sum(float v) {
    v += dpp_mov<0x111, 0xf>(0.f, v); v += dpp_mov<0x112, 0xf>(0.f, v); v += dpp_mov<0x114, 0xf>(0.f, v); v += dpp_mov<0x118, 0xf>(0.f, v);
    v += dpp_mov<0x142, 0xa>(0.f, v); v += dpp_mov<0x143, 0xc>(0.f, v); return v; }
DI float wave_scan_max(float v) { const float ninf = -INFINITY;
    v = fmaxf(v, dpp_mov<0x111, 0xf>(ninf, v)); v = fmaxf(v, dpp_mov<0x112, 0xf>(ninf, v)); v = fmaxf(v, dpp_mov<0x114, 0xf>(ninf, v)); v = fmaxf(v, dpp_mov<0x118, 0xf>(ninf, v));
    v = fmaxf(v, dpp_mov<0x142, 0xa>(ninf, v)); v = fmaxf(v, dpp_mov<0x143, 0xc>(ninf, v)); return v; }
DI float frcp(float x) { return __builtin_amdgcn_rcpf(x); }
DI float frsq(float x) { return __builtin_amdgcn_rsqf(x); }
typedef long long ss_t;
DI float ss_get(const ss_t* ss, int r) { return (float)ss[r] * (1.0f / 1048576.0f); }
DI void ss_add(ss_t* ss, int r, float v) { atomicAdd((unsigned long long*)(ss + r), (unsigned long long)__float2ll_rn(v * 1048576.0f)); }
DI void lds_wait() { asm volatile("s_waitcnt lgkmcnt(0)" ::: "memory"); }
DI void lbar() { asm volatile("s_waitcnt lgkmcnt(0)" ::: "memory"); __builtin_amdgcn_s_barrier(); asm volatile("" ::: "memory"); }

namespace pg8 {
struct EpiScale {
    static constexpr bool PERM = true, AFTER_DRAIN = false;
    bf16_t* O; int ldc; const long long* ss; int mode; const float* qg; const float* kg;
    __device__ __forceinline__ void operator()(const f32x4 (&acc)[2][2][4][2], const Unit& u, int wr, int wc, int fr, int fq) const {
        const int row0 = u.pm * BM + wr * 64 + fr;
        const int colt = u.pn * BM;
        if (mode == 0) {
            const int blk = colt >> 10, g = blk % 3, sec = blk / 3; const int dsh = (g == 0) ? 0 : (g == 1 ? 2 : 4); const int cin = (colt & 1023) + 64 * wc + 8 * fq;
            f32x4 gn[2][2];
            const float* gp = (sec == 0) ? qg + g * 64 : kg + g * 64;
#pragma unroll
            for (int bj = 0; bj < 2; ++bj)
#pragma unroll
                for (int n = 0; n < 2; ++n) gn[bj][n] = (sec < 2) ? *(const f32x4*)(gp + 32 * bj + 8 * fq + 4 * n) : (f32x4){1.f, 1.f, 1.f, 1.f};
            const float qsc = (sec == 0) ? 0.125f * 1.4426950408889634f : 1.0f;
#pragma unroll
            for (int ai = 0; ai < 2; ++ai)
#pragma unroll
                for (int m = 0; m < 4; ++m) {
                    const int r = row0 + ai * HALF + m * 16;
                    const float rs = __builtin_amdgcn_rsqf((float)ss[r] * (1.0f / 1048576.0f) * (1.0f / 1024.0f) + EPS);
                    f32x4 v[2][2]; float sq = 0.f;
#pragma unroll
                    for (int bj = 0; bj < 2; ++bj)
#pragma unroll
                        for (int n = 0; n < 2; ++n) { v[bj][n] = acc[ai][bj][m][n] * rs; sq += (v[bj][n][0] * v[bj][n][0] + v[bj][n][1] * v[bj][n][1]) + (v[bj][n][2] * v[bj][n][2] + v[bj][n][3] * v[bj][n][3]); }
                    sq = x16_sum(sq); sq = x32_sum(sq);
                    const float r2 = (sec < 2) ? qsc * __builtin_amdgcn_rsqf(sq * (1.0f / 64.0f) + EPS) : 1.0f;
                    const int bl = r >> 13, t = r & 8191; const int pr = (bl << 13) + ((t & ((1 << dsh) - 1)) << (13 - dsh)) + (t >> dsh);
                    bf16_t* rowp = O + (size_t)blk * SEC + (size_t)pr * 1024 + cin;
#pragma unroll
                    for (int bj = 0; bj < 2; ++bj) { const f32x4 v0 = v[bj][0] * gn[bj][0] * r2, v1 = v[bj][1] * gn[bj][1] * r2;
                        u32x4 w; w.x = cvt_pk_bf16(v0[0], v0[1]); w.y = cvt_pk_bf16(v0[2], v0[3]); w.z = cvt_pk_bf16(v1[0], v1[1]); w.w = cvt_pk_bf16(v1[2], v1[3]);
                        *(u32x4*)(rowp + bj * 32) = w; }
                }
            return;
        }
#pragma unroll
        for (int ai = 0; ai < 2; ++ai)
#pragma unroll
            for (int m = 0; m < 4; ++m) {
                const int r = row0 + ai * HALF + m * 16;
                const float rs = __builtin_amdgcn_rsqf((float)ss[r] * (1.0f / 1048576.0f) * (1.0f / 1024.0f) + EPS);
                bf16_t* rowp = O + (size_t)r * ldc + colt + wc * 32 + 8 * fq;
#pragma unroll
                for (int bj = 0; bj < 2; ++bj) { f32x4 v0 = acc[ai][bj][m][0] * rs, v1 = acc[ai][bj][m][1] * rs;
                    if (mode == 2) {
#pragma unroll
                        for (int e = 0; e < 4; ++e) { float a = fmaxf(v0[e], 0.f), b = fmaxf(v1[e], 0.f); v0[e] = a * a; v1[e] = b * b; } }
                    if (mode == 1 && colt >= 2048) {
#pragma unroll
                        for (int e = 0; e < 4; ++e) { v0[e] = __builtin_amdgcn_rcpf(1.0f + __builtin_amdgcn_exp2f(-1.4426950408889634f * v0[e])); v1[e] = __builtin_amdgcn_rcpf(1.0f + __builtin_amdgcn_exp2f(-1.4426950408889634f * v1[e])); } }
                    u32x4 w; w.x = cvt_pk_bf16(v0[0], v0[1]); w.y = cvt_pk_bf16(v0[2], v0[3]); w.z = cvt_pk_bf16(v1[0], v1[1]); w.w = cvt_pk_bf16(v1[2], v1[3]);
                    *(u32x4*)(rowp + bj * HALF) = w; }
            }
    }
};
struct EpiRes {
    static constexpr bool PERM = true, AFTER_DRAIN = false;
    float* X; bf16_t* XB; long long* ssn; int row_base;
    __device__ __forceinline__ void operator()(const f32x4 (&acc)[2][2][4][2], const Unit& u, int wr, int wc, int fr, int fq) const {
        const int row0 = row_base + u.pm * BM + wr * 64 + fr;
        const int col0 = u.pn * BM + wc * 32 + 8 * fq;
        u32x4 pre[2][4][2];
#pragma unroll
        for (int ai = 0; ai < 2; ++ai)
#pragma unroll
            for (int m = 0; m < 4; ++m)
#pragma unroll
                for (int bj = 0; bj < 2; ++bj) pre[ai][m][bj] = *(const u32x4*)(XB + (size_t)(row0 + ai * HALF + m * 16) * 1024 + col0 + bj * HALF);
#pragma unroll
        for (int ai = 0; ai < 2; ++ai)
#pragma unroll
            for (int m = 0; m < 4; ++m) {
                const int r = row0 + ai * HALF + m * 16; const size_t off = (size_t)r * 1024 + col0; float s = 0.f;
#pragma unroll
                for (int bj = 0; bj < 2; ++bj) {
                    const u32x4 bw = pre[ai][m][bj];
                    f32x4 b0, b1; b0[0] = __builtin_bit_cast(float, bw.x << 16); b0[1] = __builtin_bit_cast(float, bw.x & 0xffff0000u); b0[2] = __builtin_bit_cast(float, bw.y << 16); b0[3] = __builtin_bit_cast(float, bw.y & 0xffff0000u);
                    b1[0] = __builtin_bit_cast(float, bw.z << 16); b1[1] = __builtin_bit_cast(float, bw.z & 0xffff0000u); b1[2] = __builtin_bit_cast(float, bw.w << 16); b1[3] = __builtin_bit_cast(float, bw.w & 0xffff0000u);
                    const f32x4 v0 = b0 + acc[ai][bj][m][0], v1 = b1 + acc[ai][bj][m][1];
                    if (X) { *(f32x4*)(X + off + bj * HALF) = v0; *(f32x4*)(X + off + bj * HALF + 4) = v1; }
                    s += (v0[0] * v0[0] + v0[1] * v0[1]) + (v0[2] * v0[2] + v0[3] * v0[3]) + (v1[0] * v1[0] + v1[1] * v1[1]) + (v1[2] * v1[2] + v1[3] * v1[3]);
                    u32x4 w; w.x = cvt_pk_bf16(v0[0], v0[1]); w.y = cvt_pk_bf16(v0[2], v0[3]); w.z = cvt_pk_bf16(v1[0], v1[1]); w.w = cvt_pk_bf16(v1[2], v1[3]);
                    *(u32x4*)(XB + off + bj * HALF) = w; }
                s = x16_sum(s); s = x32_sum(s);
                if (fq == 0 && ssn) atomicAdd((unsigned long long*)(ssn + r), (unsigned long long)__float2ll_rn(s * 1048576.0f));
            }
    }
};
}

DI void transpose_item(const float* W, int ldw, int K, int nblk, const float* g, bf16_t* WT, LAS float* scr, int item, int lane, bool hperm) {
    const int kb = item / nblk, nb = item % nblk, k0 = 64 * kb, n0 = 64 * nb;
    const int kr = lane >> 4, n4 = (lane & 15) * 4;
    f32x4 v[16];
#pragma unroll
    for (int i = 0; i < 16; ++i) v[i] = __builtin_nontemporal_load((const f32x4*)(W + (size_t)(k0 + 4 * i + kr) * ldw + n0 + n4));
    if (g) {
#pragma unroll
        for (int i = 0; i < 16; ++i) v[i] = v[i] * g[k0 + 4 * i + kr];
    }
#pragma unroll
    for (int i = 0; i < 16; ++i) { LAS float* p = scr + (4 * i + kr) * 65 + n4; p[0] = v[i][0]; p[1] = v[i][1]; p[2] = v[i][2]; p[3] = v[i][3]; }
    lds_wait();
    const int c = lane & 7;
#pragma unroll
    for (int j = 0; j < 8; ++j) { const int n = (lane >> 3) + 8 * j; const LAS float* s = scr + (8 * c) * 65 + n;
        u32x4 o; o.x = pk2(s[0 * 65], s[1 * 65]); o.y = pk2(s[2 * 65], s[3 * 65]); o.z = pk2(s[4 * 65], s[5 * 65]); o.w = pk2(s[6 * 65], s[7 * 65]);
        int nr = n0 + n; if (hperm) nr = (nr & ~255) | (((nr >> 5) & 1) << 7) | (((nr >> 6) & 3) << 5) | (nr & 31);
        *(u32x4*)(WT + (size_t)nr * K + k0 + 8 * c) = o; }
    lds_wait();
}

struct Args { const float* in[16]; float* out; unsigned char* ws; int ph_lo, ph_hi; };

DI void prologue(const Args& a, LAS unsigned char* lds, int G, int bid) {
    const int tid = opaque_tid(), lane = tid & 63, wave = tid >> 6;
    LAS float* scr = (LAS float*)(lds + wave * 16640);
    const int gw = bid * 8 + wave, NGW = G * 8;
    unsigned char* ws = a.ws;
    int base = 0;
#pragma unroll 1
    for (int mi = 0; mi < 16; ++mi) {
        const float* W; int ldw, K, N; const float* g; bf16_t* WT;
        if (mi < 2)       { W = a.in[4] + (size_t)mi * 1024 * 9216; ldw = 9216; K = 1024; N = 9216; g = a.in[1] + (2 * mi) * 1024; WT = (bf16_t*)(ws + W_AIN + (size_t)mi * 18 * MiB); }
        else if (mi < 4)  { const int j = mi - 2; W = a.in[7] + (size_t)j * 1024 * 1024; ldw = 1024; K = 1024; N = 1024; g = nullptr; WT = (bf16_t*)(ws + W_AOUT + (size_t)j * 2 * MiB); }
        else if (mi < 6)  { const int j = mi - 4; W = a.in[8] + (size_t)j * 1024 * 3080; ldw = 3080; K = 1024; N = 3072; g = a.in[1] + (2 * j + 1) * 1024; WT = (bf16_t*)(ws + W_MIN + (size_t)j * 6 * MiB); }
        else if (mi < 8)  { const int j = mi - 6; W = a.in[13] + (size_t)j * 1024 * 1024; ldw = 1024; K = 1024; N = 1024; g = nullptr; WT = (bf16_t*)(ws + W_MOUT + (size_t)j * 2 * MiB); }
        else if (mi < 12) { const int l = mi - 8; W = a.in[14] + (size_t)l * 1024 * 4096; ldw = 4096; K = 1024; N = 4096; g = a.in[2] + l * 1024; WT = (bf16_t*)(ws + W_UP + (size_t)l * 8 * MiB); }
        else              { const int l = mi - 12; W = a.in[15] + (size_t)l * 4096 * 1024; ldw = 1024; K = 4096; N = 1024; g = nullptr; WT = (bf16_t*)(ws + W_DN + (size_t)l * 8 * MiB); }
        const int nblk = N / 64, nit = (K / 64) * nblk;
        int first = (gw - (base % NGW) + NGW) % NGW;
        for (int it = first; it < nit; it += NGW) transpose_item(W, ldw, K, nblk, g, WT, scr, it, lane, mi < 2);
        base += nit;
    }
    const float* x = a.in[0]; bf16_t* XB = (bf16_t*)(ws + WS_XB); ss_t* ss = (ss_t*)(ws + WS_SS);
    for (int m0 = gw; m0 < T_ALL; m0 += 4 * NGW) {
        f32x4 v[4][4]; float sq[4];
#pragma unroll
        for (int r = 0; r < 4; ++r) { const int m = m0 + r * NGW; const f32x4* xr = (const f32x4*)(x + (size_t)m * 1024) + lane;
#pragma unroll
            for (int j = 0; j < 4; ++j) v[r][j] = __builtin_nontemporal_load(xr + 64 * j); }
#pragma unroll
        for (int r = 0; r < 4; ++r) { float s = 0.f;
#pragma unroll
            for (int j = 0; j < 4; ++j) s += (v[r][j].x * v[r][j].x + v[r][j].y * v[r][j].y) + (v[r][j].z * v[r][j].z + v[r][j].w * v[r][j].w);
            sq[r] = wave_sum(s); }
#pragma unroll
        for (int r = 0; r < 4; ++r) { const int m = m0 + r * NGW;
            if (lane == 0) ss[m] = __float2ll_rn(sq[r] * 1048576.0f);
            u32x2* o8 = (u32x2*)(XB + (size_t)m * 1024) + lane;
#pragma unroll
            for (int j = 0; j < 4; ++j) { u32x2 w; w.x = pk2(v[r][j].x, v[r][j].y); w.y = pk2(v[r][j].z, v[r][j].w); o8[64 * j] = w; } }
    }
    for (int i = bid * 512 + tid; i < 7 * T_ALL; i += G * 512) ss[T_ALL + i] = 0;
}

DI float bucket_bias(const float* relb, int dist, int g, int h) {
    int bk;
    if (dist < 16) bk = dist;
    else { const float dd = (float)dist; int lg = 16 + (int)(logf(dd / 16.0f) / 4.852030263919617f * 16.0f); bk = lg < 31 ? lg : 31; }
    return relb[(bk * 3 + g) * 16 + h];
}

DI void attn_unit_ptrs(int u, int& rn, int& h, int& g, int& d, int& n, size_t& rowbase) {
    rn = u & 63; h = (u >> 6) & 15; g = (u >> 10) % 3; const int bl = u / 3072;
    d = (g == 0) ? 1 : (g == 1 ? 4 : 16); n = rn % (64 / d); rowbase = (size_t)(bl * 8192 + rn * 128);
}
DI u32x4 norm_pack(const u32x4 raw, const float* gain, float scale) {
    float f[8] = {bflo(raw.x), bfhi(raw.x), bflo(raw.y), bfhi(raw.y), bflo(raw.z), bfhi(raw.z), bflo(raw.w), bfhi(raw.w)};
    float s = 0.f;
#pragma unroll
    for (int j = 0; j < 8; ++j) s += f[j] * f[j];
    s += __shfl_xor(s, 1); s += __shfl_xor(s, 2); s += __shfl_xor(s, 4);
    const float rs = scale * frsq(s * (1.0f / 64.0f) + EPS);
    const f32x4 g0 = *(const f32x4*)gain, g1 = *(const f32x4*)(gain + 4);
    u32x4 o; o.x = pk2(f[0] * rs * g0[0], f[1] * rs * g0[1]); o.y = pk2(f[2] * rs * g0[2], f[3] * rs * g0[3]); o.z = pk2(f[4] * rs * g1[0], f[5] * rs * g1[1]); o.w = pk2(f[6] * rs * g1[2], f[7] * rs * g1[3]);
    return o;
}
DI void vt_store(LAS unsigned* dst, const u32x4 r0, const u32x4 r1) {
    dst[0 * 132] = (r0.x & 0xffffu) | (r1.x << 16); dst[1 * 132] = (r0.x >> 16) | (r1.x & 0xffff0000u);
    dst[2 * 132] = (r0.y & 0xffffu) | (r1.y << 16); dst[3 * 132] = (r0.y >> 16) | (r1.y & 0xffff0000u);
    dst[4 * 132] = (r0.z & 0xffffu) | (r1.z << 16); dst[5 * 132] = (r0.z >> 16) | (r1.z & 0xffff0000u);
    dst[6 * 132] = (r0.w & 0xffffu) | (r1.w << 16); dst[7 * 132] = (r0.w >> 16) | (r1.w & 0xffff0000u);
}

DI void attn_phase(LAS unsigned char* lds, bf16_t* QKV, float* LSE, const float* qg, const float* kg, const float* relb, int G, int bid) {
    const int tid = opaque_tid(), lane = tid & 63, w = tid >> 6, fr = lane & 15, fq = lane >> 4;
    LAS bf16_t* Qs = (LAS bf16_t*)lds;
    LAS bf16_t* Ks = Qs + 128 * 72;
    LAS unsigned* Vt32 = (LAS unsigned*)(Ks + 256 * 72);
    LAS bf16_t* Vt = (LAS bf16_t*)Vt32;
    LAS float* tab = (LAS float*)(Vt32 + 64 * 132);
    const int per = (6144 + G - 1) / G; const int u0 = bid * per; int u1 = u0 + per; if (u1 > 6144) u1 = 6144;
    const int kp2 = tid & 63, vpc = tid >> 6;
    u32x4 pq[2], pk[2], pv[2];
    int rn, h, g, d, n; size_t rowbase;
    if (u0 < u1) { attn_unit_ptrs(u0, rn, h, g, d, n, rowbase);
        const bf16_t* qp = QKV + (size_t)g * SEC + rowbase * 1024 + h * 64; const bf16_t* kp = qp + 3 * SEC; const bf16_t* vp = qp + 6 * SEC;
#pragma unroll
        for (int it = 0; it < 2; ++it) { const int idx = tid + 512 * it, row = idx >> 3, pc = idx & 7; pq[it] = *(const u32x4*)(qp + (size_t)row * 1024 + pc * 8); pk[it] = *(const u32x4*)(kp + (size_t)row * 1024 + pc * 8); }
        pv[0] = *(const u32x4*)(vp + (size_t)(2 * kp2) * 1024 + vpc * 8); pv[1] = *(const u32x4*)(vp + (size_t)(2 * kp2 + 1) * 1024 + vpc * 8); }
    for (int u = u0; u < u1; ++u) {
        attn_unit_ptrs(u, rn, h, g, d, n, rowbase);
        bf16_t* qp = QKV + (size_t)g * SEC + rowbase * 1024 + h * 64;
        const int slot = n & 1;
        lbar();
        if (u == u0 || n == 0) { if (tid < 160) tab[tid] = (tid >= 16 && tid <= 144) ? 1.4426950408889634f * bucket_bias(relb, (tid - 16) * d, g, h) : 0.f; }
        if (n == 0) {
#pragma unroll
            for (int i = 0; i < 8; ++i) { const int idx = tid + 512 * i; Vt32[(idx >> 6) * 132 + (slot ^ 1) * 64 + (idx & 63)] = 0u; }
        } else if (u == u0) {
            const bf16_t* kp = qp + 3 * SEC - (size_t)128 * 1024; const bf16_t* vp = qp + 6 * SEC - (size_t)128 * 1024;
#pragma unroll
            for (int it = 0; it < 2; ++it) { const int idx = tid + 512 * it, row = idx >> 3, pc = idx & 7;
                const u32x4 raw = *(const u32x4*)(kp + (size_t)row * 1024 + pc * 8);
                *(LAS u32x4*)(Ks + ((slot ^ 1) * 128 + row) * 72 + pc * 8) = raw; }
            const u32x4 r0 = *(const u32x4*)(vp + (size_t)(2 * kp2) * 1024 + vpc * 8), r1 = *(const u32x4*)(vp + (size_t)(2 * kp2 + 1) * 1024 + vpc * 8);
            vt_store(Vt32 + (8 * vpc) * 132 + (slot ^ 1) * 64 + kp2, r0, r1);
        }
#pragma unroll
        for (int it = 0; it < 2; ++it) { const int idx = tid + 512 * it, row = idx >> 3, pc = idx & 7;
            *(LAS u32x4*)(Qs + row * 72 + pc * 8) = pq[it];
            *(LAS u32x4*)(Ks + (slot * 128 + row) * 72 + pc * 8) = pk[it]; }
        vt_store(Vt32 + (8 * vpc) * 132 + slot * 64 + kp2, pv[0], pv[1]);
        lbar();
        if (u + 1 < u1) {
            int rn2, h2, g2, d2, n2; size_t rb2; attn_unit_ptrs(u + 1, rn2, h2, g2, d2, n2, rb2);
            const bf16_t* qp2 = QKV + (size_t)g2 * SEC + rb2 * 1024 + h2 * 64; const bf16_t* kp2p = qp2 + 3 * SEC; const bf16_t* vp2 = qp2 + 6 * SEC;
#pragma unroll
            for (int it = 0; it < 2; ++it) { const int idx = tid + 512 * it, row = idx >> 3, pc = idx & 7; pq[it] = *(const u32x4*)(qp2 + (size_t)row * 1024 + pc * 8); pk[it] = *(const u32x4*)(kp2p + (size_t)row * 1024 + pc * 8); }
            pv[0] = *(const u32x4*)(vp2 + (size_t)(2 * kp2) * 1024 + vpc * 8); pv[1] = *(const u32x4*)(vp2 + (size_t)(2 * kp2 + 1) * 1024 + vpc * 8);
        }
        bf16x8 qf[2];
        qf[0] = *(const LAS bf16x8*)(Qs + (16 * w + fr) * 72 + 8 * fq); qf[1] = *(const LAS bf16x8*)(Qs + (16 * w + fr) * 72 + 32 + 8 * fq);
        f32x4 sc[9];
#pragma unroll
        for (int i = 0; i < 9; ++i) { const int tau = w + i; const int kr = ((((n + 1 + (tau >> 3)) & 1) << 7) | ((tau & 7) << 4)) + fr; f32x4 acc = (f32x4){0.f, 0.f, 0.f, 0.f};
            const bf16x8 a0 = *(const LAS bf16x8*)(Ks + kr * 72 + 8 * fq), a1 = *(const LAS bf16x8*)(Ks + kr * 72 + 32 + 8 * fq);
            acc = __builtin_amdgcn_mfma_f32_16x16x32_bf16(a0, qf[0], acc, 0, 0, 0);
            acc = __builtin_amdgcn_mfma_f32_16x16x32_bf16(a1, qf[1], acc, 0, 0, 0);
            sc[i] = acc; }
        float mx = -INFINITY;
        const LAS float* tb = tab + (16 + fr - 4 * fq - 3);
        const int dlt = fr - 4 * fq;
        float bv[9][4];
#pragma unroll
        for (int i = 0; i < 9; ++i)
#pragma unroll
            for (int j = 0; j < 4; ++j) bv[i][j] = tb[16 * (8 - i) + (3 - j)];
#pragma unroll
        for (int i = 0; i < 9; ++i)
#pragma unroll
            for (int j = 0; j < 4; ++j) asm volatile("" : "+v"(bv[i][j]));
#pragma unroll
        for (int i = 0; i < 9; ++i) { const bool tv = (n > 0) || (w + i >= 8);
#pragma unroll
            for (int j = 0; j < 4; ++j) { bool valid = tv;
                if (i == 0) valid = valid && (dlt - j <= 0);
                if (i == 8) valid = valid && (dlt - j >= 0);
                const float v = valid ? sc[i][j] + bv[i][j] : -INFINITY; sc[i][j] = v; mx = fmaxf(mx, v); } }
        mx = x16_max(mx); mx = x32_max(mx);
        float sum = 0.f;
#pragma unroll
        for (int i = 0; i < 9; ++i)
#pragma unroll
            for (int j = 0; j < 4; ++j) { const float p = __builtin_amdgcn_exp2f(sc[i][j] - mx); sc[i][j] = p; sum += p; }
        sum = x16_sum(sum); sum = x32_sum(sum);
        f32x4 o[4];
#pragma unroll
        for (int et = 0; et < 4; ++et) o[et] = (f32x4){0.f, 0.f, 0.f, 0.f};
#pragma unroll
        for (int pi = 0; pi < 5; ++pi) { const int ia = 2 * pi, ib = (2 * pi + 1 < 9) ? 2 * pi + 1 : 8;
            u32x4 pw; pw.x = pk2(sc[ia][0], sc[ia][1]); pw.y = pk2(sc[ia][2], sc[ia][3]);
            if (2 * pi + 1 < 9) { pw.z = pk2(sc[ib][0], sc[ib][1]); pw.w = pk2(sc[ib][2], sc[ib][3]); } else { pw.z = 0u; pw.w = 0u; }
            const bf16x8 pb = __builtin_bit_cast(bf16x8, pw);
            const int ta = w + ia; int tb = w + 2 * pi + 1; if (tb > 15) tb = 15;
            const int ca = ((((n + 1 + (ta >> 3)) & 1) << 7) | ((ta & 7) << 4)) + 4 * fq, cb = ((((n + 1 + (tb >> 3)) & 1) << 7) | ((tb & 7) << 4)) + 4 * fq;
#pragma unroll
            for (int et = 0; et < 4; ++et) { const LAS bf16_t* vr = Vt + (16 * et + fr) * 264;
                const u32x2 lo = *(const LAS u32x2*)(vr + ca), hi = *(const LAS u32x2*)(vr + cb);
                u32x4 aw; aw.x = lo.x; aw.y = lo.y; aw.z = hi.x; aw.w = hi.y;
                o[et] = __builtin_amdgcn_mfma_f32_16x16x32_bf16(__builtin_bit_cast(bf16x8, aw), pb, o[et], 0, 0, 0); } }
        const float inv = frcp(sum);
        bf16_t* orow = qp + (size_t)(16 * w + fr) * 1024 + 4 * fq;
#pragma unroll
        for (int et = 0; et < 4; ++et) { u32x2 ow; ow.x = pk2(o[et][0] * inv, o[et][1] * inv); ow.y = pk2(o[et][2] * inv, o[et][3] * inv); *(u32x2*)(orow + 16 * et) = ow; }
        if (fq == 0) LSE[((size_t)g * TH + rowbase + 16 * w + fr) * 16 + h] = (mx + __log2f(sum)) * 0.6931471805599453f;
    }
}

DI void merge_phase(bf16_t* QKV, const float* LSE, int G, int bid) {
    const int tid = opaque_tid(), lane = tid & 63, gw = bid * 8 + (tid >> 6), NGW = G * 8;
    const int h = lane >> 2, col = 16 * lane;
    for (int tl0 = gw; tl0 < TH; tl0 += 4 * NGW) {
        u32x4 a[4][2], b[4][2], c[4][2]; float l0[4], l1[4], l2[4]; bf16_t* p0[4];
#pragma unroll
        for (int r = 0; r < 4; ++r) { const int tl = tl0 + r * NGW; const int bl = tl >> 13, t = tl & 8191;
            const int pr0 = tl, pr1 = (bl << 13) + ((t & 3) << 11) + (t >> 2), pr2 = (bl << 13) + ((t & 15) << 9) + (t >> 4);
            l0[r] = LSE[((size_t)0 * TH + pr0) * 16 + h]; l1[r] = LSE[((size_t)1 * TH + pr1) * 16 + h]; l2[r] = LSE[((size_t)2 * TH + pr2) * 16 + h];
            p0[r] = QKV + (size_t)pr0 * 1024 + col; const bf16_t* p1 = QKV + SEC + (size_t)pr1 * 1024 + col; const bf16_t* p2 = QKV + 2 * SEC + (size_t)pr2 * 1024 + col;
#pragma unroll
            for (int q = 0; q < 2; ++q) { a[r][q] = *(const u32x4*)(p0[r] + 8 * q); b[r][q] = *(const u32x4*)(p1 + 8 * q); c[r][q] = *(const u32x4*)(p2 + 8 * q); } }
#pragma unroll
        for (int r = 0; r < 4; ++r) {
            const float m = fmaxf(l0[r], fmaxf(l1[r], l2[r])); float w0 = __expf(l0[r] - m), w1 = __expf(l1[r] - m), w2 = __expf(l2[r] - m); const float is = frcp(w0 + w1 + w2); w0 *= is; w1 *= is; w2 *= is;
#pragma unroll
            for (int q = 0; q < 2; ++q) { const u32x4 A = a[r][q], B = b[r][q], C = c[r][q]; u32x4 o;
                o.x = pk2(w0 * bflo(A.x) + w1 * bflo(B.x) + w2 * bflo(C.x), w0 * bfhi(A.x) + w1 * bfhi(B.x) + w2 * bfhi(C.x));
                o.y = pk2(w0 * bflo(A.y) + w1 * bflo(B.y) + w2 * bflo(C.y), w0 * bfhi(A.y) + w1 * bfhi(B.y) + w2 * bfhi(C.y));
                o.z = pk2(w0 * bflo(A.z) + w1 * bflo(B.z) + w2 * bflo(C.z), w0 * bfhi(A.z) + w1 * bfhi(B.z) + w2 * bfhi(C.z));
                o.w = pk2(w0 * bflo(A.w) + w1 * bflo(B.w) + w2 * bflo(C.w), w0 * bfhi(A.w) + w1 * bfhi(B.w) + w2 * bfhi(C.w));
                *(u32x4*)(p0[r] + 8 * q) = o; }
        }
    }
}

DI void gates_phase(LAS unsigned char* lds, const bf16_t* X, const ss_t* ss, const float* win  , const float* ng, const float* gbias, float* GATES, int G, int bid) {
    const int tid = opaque_tid(), lane = tid & 63, gw = bid * 8 + (tid >> 6), NGW = G * 8;
    LAS float* wg = (LAS float*)lds;
    __syncthreads();
    for (int k = tid; k < 1024; k += 512) { const float gv = ng[k]; const f32x4 a = *(const f32x4*)(win + (size_t)k * 3080 + 3072), b = *(const f32x4*)(win + (size_t)k * 3080 + 3076);
        *(LAS f32x4*)(wg + k * 8) = a * gv; *(LAS f32x4*)(wg + k * 8 + 4) = b * gv; }
    __syncthreads();
    for (int m0 = gw; m0 < T_ALL; m0 += 2 * NGW) {
        float acc[2][8];
#pragma unroll
        for (int r = 0; r < 2; ++r)
#pragma unroll
            for (int j = 0; j < 8; ++j) acc[r][j] = 0.f;
        const bf16_t* xr0 = X + (size_t)m0 * 1024; const bf16_t* xr1 = X + (size_t)(m0 + NGW) * 1024;
#pragma unroll 4
        for (int i = 0; i < 16; ++i) { const int k = lane + 64 * i; const float x0 = __builtin_bit_cast(float, (unsigned)xr0[k] << 16), x1 = __builtin_bit_cast(float, (unsigned)xr1[k] << 16); const f32x4 a = *(const LAS f32x4*)(wg + k * 8), b = *(const LAS f32x4*)(wg + k * 8 + 4);
#pragma unroll
            for (int e = 0; e < 4; ++e) { acc[0][e] += x0 * a[e]; acc[0][4 + e] += x0 * b[e]; acc[1][e] += x1 * a[e]; acc[1][4 + e] += x1 * b[e]; } }
#pragma unroll
        for (int r = 0; r < 2; ++r) {
            float v4[4], v2[2], v1;
            { const bool up = lane & 1;
#pragma unroll
              for (int e = 0; e < 4; ++e) { const float keep = up ? acc[r][4 + e] : acc[r][e], send = up ? acc[r][e] : acc[r][4 + e]; v4[e] = keep + __shfl_xor(send, 1); } }
            { const bool up = lane & 2;
#pragma unroll
              for (int e = 0; e < 2; ++e) { const float keep = up ? v4[2 + e] : v4[e], send = up ? v4[e] : v4[2 + e]; v2[e] = keep + __shfl_xor(send, 2); } }
            { const bool up = lane & 4; const float keep = up ? v2[1] : v2[0], send = up ? v2[0] : v2[1]; v1 = keep + __shfl_xor(send, 4); }
            v1 += __shfl_xor(v1, 8); v1 += __shfl_xor(v1, 16); v1 += __shfl_xor(v1, 32);
            const int m = m0 + r * NGW;
            const float rs = frsq(ss_get(ss, m) * (1.0f / 1024.0f) + EPS);
            if (lane < 8) { const int j = (lane & 1) * 4 + ((lane >> 1) & 1) * 2 + ((lane >> 2) & 1);
                float v = v1 * rs + gbias[j];
                if (j >= 4) v = fminf(v, 0.f) - log1pf(expf(-fabsf(v)));
                GATES[(size_t)m * 8 + j] = v; }
        }
    }
    __syncthreads();
}

DI float silu(float y) { return y * frcp(1.0f + __expf(-y)); }
DI f32x16 mfma32(bf16x8 a, bf16x8 b, f32x16 c) { return __builtin_amdgcn_mfma_f32_32x32x16_bf16(a, b, c, 0, 0, 0); }

DI void conv2(const u32x4 (&x)[5], const LAS float* cw, int dd, float (&y0)[8], float (&y1)[8]) {
    float xf[5][8];
#pragma unroll
    for (int r = 0; r < 5; ++r) { xf[r][0] = bflo(x[r].x); xf[r][1] = bfhi(x[r].x); xf[r][2] = bflo(x[r].y); xf[r][3] = bfhi(x[r].y); xf[r][4] = bflo(x[r].z); xf[r][5] = bfhi(x[r].z); xf[r][6] = bflo(x[r].w); xf[r][7] = bfhi(x[r].w); }
#pragma unroll
    for (int j = 0; j < 8; ++j) { const float b = cw[4 * 128 + dd + j]; float a0 = b, a1 = b;
#pragma unroll
        for (int tp = 0; tp < 4; ++tp) { const float c = cw[tp * 128 + dd + j]; a0 += xf[tp][j] * c; a1 += xf[tp + 1][j] * c; }
        y0[j] = silu(a0); y1[j] = silu(a1); }
}

template <bool P2>
DI void ml_pass(LAS unsigned char* lds, const bf16_t* PROJ, const float* GATES, float* STATE, float* SC, bf16_t* YM,
                const float* convw, const float* convb, const float* ogain, int G, int bid) {
    const int tid = opaque_tid(), lane = tid & 63, w = tid >> 6, l31 = lane & 31, hi = lane >> 5;
    LAS bf16_t* Qs = (LAS bf16_t*)lds;
    LAS bf16_t* Ks = (LAS bf16_t*)(lds + 17408);
    LAS bf16_t* Kt = (LAS bf16_t*)(lds + 34816);
    LAS bf16_t* Vt = (LAS bf16_t*)(lds + 53248);
    LAS bf16_t* Ws = (LAS bf16_t*)(lds + 90112);
    LAS bf16_t* OUTs = (LAS bf16_t*)(lds + 99328);
    LAS float* ns = (LAS float*)(lds + 133120);
    LAS float* gs = (LAS float*)(lds + 133632);
    LAS float* dq = (LAS float*)(lds + 133888);
    LAS float* denp = (LAS float*)(lds + 134144);
    LAS float* ssq = (LAS float*)(lds + 134656);
    LAS float* cw = (LAS float*)(lds + 136704);
    LAS unsigned* Kt32 = (LAS unsigned*)Kt; LAS unsigned* Vt32 = (LAS unsigned*)Vt;
    for (int uid = bid; uid < 256; uid += G) {
        const int b = uid >> 6, h = (uid >> 4) & 3, sg = uid & 15;
        lbar();
        for (int idx = tid; idx < 1280; idx += 512) { const int qk = idx / 640, r = idx % 640, tp = r >> 7, dd = r & 127, ch = qk * 512 + 128 * h + dd;
            cw[idx] = tp < 4 ? convw[tp * 1024 + ch] : convb[ch]; }
        f32x16 Ct[4]; float m_prev = 0.f, gtot = 0.f;
        float* st = STATE + (size_t)uid * ST_STRIDE;
        if (P2) {
#pragma unroll
            for (int dt = 0; dt < 4; ++dt)
#pragma unroll
                for (int i = 0; i < 16; ++i) Ct[dt][i] = st[((w * 4 + dt) * 16 + i) * 64 + lane];
            if (tid < 128) ns[tid] = st[32768 + tid];
            for (int s2 = 0; s2 < sg; ++s2) { const float ml = SC[(uid - sg + s2) * 2], gsg = SC[(uid - sg + s2) * 2 + 1]; m_prev = fmaxf(gsg + m_prev, ml); }
        } else {
#pragma unroll
            for (int dt = 0; dt < 4; ++dt)
#pragma unroll
                for (int i = 0; i < 16; ++i) Ct[dt][i] = 0.f;
            if (tid < 128) ns[tid] = 0.f;
        }
        lbar();
#pragma unroll 1
        for (int c = 0; c < 8; ++c) {
            int tid_o = tid; asm volatile("" : "+v"(tid_o));
            const int tid = tid_o, lane = tid & 63, w = __builtin_amdgcn_readfirstlane(tid >> 6), l31 = lane & 31, hi = lane >> 5;
            const int t0 = sg * 512 + c * 64; const size_t row0 = (size_t)b * 8192 + t0;
            const float li = GATES[(row0 + lane) * 8 + h], lf = GATES[(row0 + lane) * 8 + 4 + h];
            const float bcum = wave_scan_sum(lf);
            const float gq = li - bcum; const float pm = wave_scan_max(gq);
            const float b_last = __builtin_bit_cast(float, __builtin_amdgcn_readlane(__builtin_bit_cast(int, bcum), 63)), pm63 = __builtin_bit_cast(float, __builtin_amdgcn_readlane(__builtin_bit_cast(int, pm), 63));
            const float m_new = fmaxf(b_last + m_prev, b_last + pm63);
            const float decay = __expf(b_last + m_prev - m_new);
            const float wk = __expf(b_last + gq - m_new);
            const float mt = fmaxf(bcum + m_prev, bcum + pm);
            const float inter = __expf(bcum + m_prev - mt);
            if (w == 0) gs[lane] = gq;
            const int sp = tid & 31, pc = tid >> 5;
            {
                u32x4 xr[5];
                const bf16_t* kb = PROJ + (row0 + 2 * sp) * 3072 + 512 + 128 * h + 8 * pc;
#pragma unroll
                for (int r = 0; r < 5; ++r) { const int tt = t0 + 2 * sp - 3 + r; xr[r] = (tt >= 0) ? *(const u32x4*)(kb + ((long)r - 3) * 3072) : (u32x4){0u, 0u, 0u, 0u}; }
                float y0[8], y1[8]; conv2(xr, cw + 640, 8 * pc, y0, y1);
                if (P2) { u32x4 o; o.x = pk2(y0[0], y0[1]); o.y = pk2(y0[2], y0[3]); o.z = pk2(y0[4], y0[5]); o.w = pk2(y0[6], y0[7]); *(LAS u32x4*)(Ks + (2 * sp) * 136 + 8 * pc) = o;
                    o.x = pk2(y1[0], y1[1]); o.y = pk2(y1[2], y1[3]); o.z = pk2(y1[4], y1[5]); o.w = pk2(y1[6], y1[7]); *(LAS u32x4*)(Ks + (2 * sp + 1) * 136 + 8 * pc) = o; }
                const float wk0 = __shfl(wk, 2 * sp), wk1 = __shfl(wk, 2 * sp + 1);
#pragma unroll
                for (int j = 0; j < 8; ++j) Kt32[(8 * pc + j) * 36 + sp] = pk2(y0[j] * wk0, y1[j] * wk1);
                asm volatile("" ::: "memory");
                if (P2) {
                    const bf16_t* qb = PROJ + (row0 + 2 * sp) * 3072 + 128 * h + 8 * pc;
#pragma unroll
                    for (int r = 0; r < 5; ++r) { const int tt = t0 + 2 * sp - 3 + r; xr[r] = (tt >= 0) ? *(const u32x4*)(qb + ((long)r - 3) * 3072) : (u32x4){0u, 0u, 0u, 0u}; }
                    conv2(xr, cw, 8 * pc, y0, y1);
                    const float qs = 0.08838834764831845f;
                    u32x4 o; o.x = pk2(y0[0] * qs, y0[1] * qs); o.y = pk2(y0[2] * qs, y0[3] * qs); o.z = pk2(y0[4] * qs, y0[5] * qs); o.w = pk2(y0[6] * qs, y0[7] * qs); *(LAS u32x4*)(Qs + (2 * sp) * 136 + 8 * pc) = o;
                    o.x = pk2(y1[0] * qs, y1[1] * qs); o.y = pk2(y1[2] * qs, y1[3] * qs); o.z = pk2(y1[4] * qs, y1[5] * qs); o.w = pk2(y1[6] * qs, y1[7] * qs); *(LAS u32x4*)(Qs + (2 * sp + 1) * 136 + 8 * pc) = o;
                }
            }
            asm volatile("" ::: "memory");
#pragma unroll 1
            for (int it = 0; it < 2; ++it) { const int idx = tid + 512 * it, sp2 = idx & 31, pc2 = idx >> 5;
                const bf16_t* vb = PROJ + (row0 + 2 * sp2) * 3072 + 1024 + 256 * h + 8 * pc2;
                const u32x4 r0 = *(const u32x4*)vb, r1 = *(const u32x4*)(vb + 3072);
                LAS unsigned* dst = Vt32 + (8 * pc2) * 36 + sp2;
                dst[0 * 36] = (r0.x & 0xffffu) | (r1.x << 16); dst[1 * 36] = (r0.x >> 16) | (r1.x & 0xffff0000u);
                dst[2 * 36] = (r0.y & 0xffffu) | (r1.y << 16); dst[3 * 36] = (r0.y >> 16) | (r1.y & 0xffff0000u);
                dst[4 * 36] = (r0.z & 0xffffu) | (r1.z << 16); dst[5 * 36] = (r0.z >> 16) | (r1.z & 0xffff0000u);
                dst[6 * 36] = (r0.w & 0xffffu) | (r1.w << 16); dst[7 * 36] = (r0.w >> 16) | (r1.w & 0xffff0000u); }
            lbar();
            if (P2) {
                if (w < 4) {
                    const int stl = w & 1, ttl = w >> 1; const int t = 32 * ttl + l31;
                    float rowsum = 0.f;
                    if (w == 1) {
#pragma unroll
                        for (int i4 = 0; i4 < 4; ++i4) *(LAS u32x2*)(Ws + t * 72 + 32 + 8 * i4 + 4 * hi) = (u32x2){0u, 0u};
                    } else {
                        f32x16 acc;
#pragma unroll
                        for (int i = 0; i < 16; ++i) acc[i] = 0.f;
#pragma unroll
                        for (int kq = 0; kq < 8; ++kq) { const bf16x8 a = *(const LAS bf16x8*)(Ks + (32 * stl + l31) * 136 + 16 * kq + 8 * hi), bb = *(const LAS bf16x8*)(Qs + t * 136 + 16 * kq + 8 * hi);
                            acc = mfma32(a, bb, acc); }
                        const float bc_t = __shfl(bcum, t), mt_t = __shfl(mt, t);
#pragma unroll
                        for (int i4 = 0; i4 < 4; ++i4) { const int s0 = 32 * stl + 8 * i4 + 4 * hi; const f32x4 g4 = *(const LAS f32x4*)(gs + s0); float v[4];
#pragma unroll
                            for (int e = 0; e < 4; ++e) { const int s = s0 + e; v[e] = (s <= t) ? acc[4 * i4 + e] * __expf(bc_t + g4[e] - mt_t) : 0.f; rowsum += v[e]; }
                            u32x2 o; o.x = pk2(v[0], v[1]); o.y = pk2(v[2], v[3]); *(LAS u32x2*)(Ws + t * 72 + s0) = o; }
                    }
                    rowsum = x32_sum(rowsum);
                    if (hi == 0) denp[stl * 64 + t] = rowsum;
                } else {
                    const int t2 = (tid - 256) >> 2, qtr = tid & 3; float s = 0.f;
#pragma unroll
                    for (int q8 = 0; q8 < 4; ++q8) { const int d0 = 32 * qtr + 8 * q8; const u32x4 qv = *(const LAS u32x4*)(Qs + t2 * 136 + d0); const f32x4 n0 = *(const LAS f32x4*)(ns + d0), n1 = *(const LAS f32x4*)(ns + d0 + 4);
                        s += bflo(qv.x) * n0[0] + bfhi(qv.x) * n0[1] + bflo(qv.y) * n0[2] + bfhi(qv.y) * n0[3] + bflo(qv.z) * n1[0] + bfhi(qv.z) * n1[1] + bflo(qv.w) * n1[2] + bfhi(qv.w) * n1[3]; }
                    s += __shfl_xor(s, 1); s += __shfl_xor(s, 2);
                    if (qtr == 0) dq[t2] = s;
                }
                lbar();
            }
            f32x16 oacc[2];
            if (P2) {
#pragma unroll
                for (int i = 0; i < 16; ++i) { oacc[0][i] = 0.f; oacc[1][i] = 0.f; }
#pragma unroll
                for (int dt = 0; dt < 4; ++dt)
#pragma unroll
                    for (int kq = 0; kq < 2; ++kq) {
                        u32x4 aw; aw.x = pk2(Ct[dt][8 * kq + 0], Ct[dt][8 * kq + 1]); aw.y = pk2(Ct[dt][8 * kq + 2], Ct[dt][8 * kq + 3]); aw.z = pk2(Ct[dt][8 * kq + 4], Ct[dt][8 * kq + 5]); aw.w = pk2(Ct[dt][8 * kq + 6], Ct[dt][8 * kq + 7]);
                        const bf16x8 a = __builtin_bit_cast(bf16x8, aw);
#pragma unroll
                        for (int tt = 0; tt < 2; ++tt) { const LAS bf16_t* qr = Qs + (32 * tt + l31) * 136 + 32 * dt + 16 * kq + 4 * hi;
                            const u32x2 lo = *(const LAS u32x2*)qr, hv = *(const LAS u32x2*)(qr + 8); u32x4 bw; bw.x = lo.x; bw.y = lo.y; bw.z = hv.x; bw.w = hv.y;
                            oacc[tt] = mfma32(a, __builtin_bit_cast(bf16x8, bw), oacc[tt]); }
                    }
#pragma unroll
                for (int tt = 0; tt < 2; ++tt) { const float itv = __shfl(inter, 32 * tt + l31);
#pragma unroll
                    for (int i = 0; i < 16; ++i) oacc[tt][i] *= itv; }
            }
            asm volatile("" ::: "memory");
            bf16x8 vf[4];
#pragma unroll
            for (int kq = 0; kq < 4; ++kq) vf[kq] = *(const LAS bf16x8*)(Vt + (32 * w + l31) * 72 + 16 * kq + 8 * hi);
            if (P2) {
#pragma unroll
                for (int kq = 0; kq < 4; ++kq)
#pragma unroll
                    for (int tt = 0; tt < 2; ++tt) { const bf16x8 wf = *(const LAS bf16x8*)(Ws + (32 * tt + l31) * 72 + 16 * kq + 8 * hi); oacc[tt] = mfma32(vf[kq], wf, oacc[tt]); }
            }
            asm volatile("" ::: "memory");
            if (!P2 || c < 7) {
#pragma unroll
            for (int dt = 0; dt < 4; ++dt) {
#pragma unroll
                for (int i = 0; i < 16; ++i) Ct[dt][i] *= decay;
#pragma unroll
                for (int kq = 0; kq < 4; ++kq) { const bf16x8 kf = *(const LAS bf16x8*)(Kt + (32 * dt + l31) * 72 + 16 * kq + 8 * hi); Ct[dt] = mfma32(kf, vf[kq], Ct[dt]); }
            }
            }
            asm volatile("" ::: "memory");
            if (tid < 128) { float s = 0.f;
#pragma unroll
                for (int q8 = 0; q8 < 8; ++q8) { const u32x4 kv = *(const LAS u32x4*)(Kt + tid * 72 + 8 * q8); s += (bflo(kv.x) + bfhi(kv.x)) + (bflo(kv.y) + bfhi(kv.y)) + (bflo(kv.z) + bfhi(kv.z)) + (bflo(kv.w) + bfhi(kv.w)); }
                ns[tid] = decay * ns[tid] + s; }
            if (P2) {
#pragma unroll
                for (int tt = 0; tt < 2; ++tt) { const int t = 32 * tt + l31; const float itv = __shfl(inter, t), mt_t = __shfl(mt, t);
                    const float den = itv * dq[t] + denp[t] + denp[64 + t];
                    const float rd = frcp(fmaxf(fabsf(den), __expf(-mt_t))); float sq = 0.f;
#pragma unroll
                    for (int i4 = 0; i4 < 4; ++i4) { float v[4];
#pragma unroll
                        for (int e = 0; e < 4; ++e) { v[e] = oacc[tt][4 * i4 + e] * rd; sq += v[e] * v[e]; }
                        u32x2 o; o.x = pk2(v[0], v[1]); o.y = pk2(v[2], v[3]); *(LAS u32x2*)(OUTs + t * 264 + 32 * w + 8 * i4 + 4 * hi) = o; }
                    sq = x32_sum(sq);
                    if (hi == 0) ssq[t * 8 + w] = sq; }
            }
            lbar();
            if (P2) {
#pragma unroll
                for (int it = 0; it < 4; ++it) { const int idx = tid + 512 * it, t = idx >> 5, pc3 = idx & 31;
                    const f32x4 q0 = *(const LAS f32x4*)(ssq + t * 8), q1 = *(const LAS f32x4*)(ssq + t * 8 + 4);
                    const float ssum = ((q0[0] + q0[1]) + (q0[2] + q0[3])) + ((q1[0] + q1[1]) + (q1[2] + q1[3]));
                    const float rstd = frsq(ssum * (1.0f / 256.0f) + EPS);
                    const u32x4 hv = *(const LAS u32x4*)(OUTs + t * 264 + 8 * pc3);
                    const u32x4 op = *(const u32x4*)(PROJ + (row0 + t) * 3072 + 2048 + 256 * h + 8 * pc3);
                    const f32x4 g0 = *(const f32x4*)(ogain + h * 256 + 8 * pc3), g1 = *(const f32x4*)(ogain + h * 256 + 8 * pc3 + 4);
                    float hvf[8] = {bflo(hv.x), bfhi(hv.x), bflo(hv.y), bfhi(hv.y), bflo(hv.z), bfhi(hv.z), bflo(hv.w), bfhi(hv.w)};
                    float opf[8] = {bflo(op.x), bfhi(op.x), bflo(op.y), bfhi(op.y), bflo(op.z), bfhi(op.z), bflo(op.w), bfhi(op.w)};
                    float y[8];
#pragma unroll
                    for (int j = 0; j < 8; ++j) y[j] = hvf[j] * rstd * (j < 4 ? g0[j & 3] : g1[j & 3]) * opf[j];
                    u32x4 o; o.x = pk2(y[0], y[1]); o.y = pk2(y[2], y[3]); o.z = pk2(y[4], y[5]); o.w = pk2(y[6], y[7]);
                    *(u32x4*)(YM + (row0 + t) * 1024 + 256 * h + 8 * pc3) = o; }
            }
            m_prev = m_new; gtot += b_last;
        }
        if (!P2) {
#pragma unroll
            for (int dt = 0; dt < 4; ++dt)
#pragma unroll
                for (int i = 0; i < 16; ++i) st[((w * 4 + dt) * 16 + i) * 64 + lane] = Ct[dt][i];
            lbar();
            if (tid < 128) st[32768 + tid] = ns[tid];
            if (tid == 0) { SC[uid * 2] = m_prev; SC[uid * 2 + 1] = gtot; }
        }
    }
}

DI void scan_phase(float* STATE, const float* SC, int G, int bid) {
    const int total = 16 * ST_STRIDE;
    for (int el = bid * 512 + opaque_tid(); el < total; el += G * 512) {
        const int bh = el / ST_STRIDE, e = el % ST_STRIDE; float cur = 0.f, mcur = 0.f;
#pragma unroll
        for (int s2 = 0; s2 < 16; ++s2) { const int uid = bh * 16 + s2; float* p = STATE + (size_t)uid * ST_STRIDE + e; const float l = *p; *p = cur;
            const float ml = SC[uid * 2], gsg = SC[uid * 2 + 1]; const float mo = fmaxf(gsg + mcur, ml);
            cur = __expf(gsg + mcur - mo) * cur + __expf(ml - mo) * l; mcur = mo; }
    }
}

#define XB_TMO      128
#define XB_XCNT(j)  (256  + 64 * (j))
#define XB_XSUB(j)  (1280 + 64 * (j))
#define XB_XGEN(j)  (2304 + 64 * (j))
#define XB_TOP      3328
#define XB_TOPGEN   3392
#define XCD_BAR_WORDS 3456
#define XB_SPIN_CAP (1u << 18)

__device__ __forceinline__ unsigned xb_ld(unsigned* p)              { return __hip_atomic_load(p, __ATOMIC_RELAXED, __HIP_MEMORY_SCOPE_AGENT); }
__device__ __forceinline__ unsigned xb_add(unsigned* p, unsigned v) { return __hip_atomic_fetch_add(p, v, __ATOMIC_RELAXED, __HIP_MEMORY_SCOPE_AGENT); }
__device__ __forceinline__ unsigned xb_xcc_id() { return (unsigned)__builtin_amdgcn_s_getreg((3 << 11) | 20) & 0xFu; }
#define XB_SPIN(cond, bar) do { unsigned _sp = 0; while (cond) { __builtin_amdgcn_s_sleep(1); \
    if ((++_sp & 255u) == 0u) { if (xb_ld(&(bar)[XB_TMO])) break; if (_sp > XB_SPIN_CAP) { atomicAdd(&(bar)[XB_TMO], 1u); break; } } } } while (0)

struct XcdBarrier {
    unsigned* bar; unsigned x;
    volatile LAS unsigned* st;
};

__device__ __forceinline__ XcdBarrier xcd_barrier_post(unsigned* bar, volatile LAS unsigned* st) {
    XcdBarrier b; b.bar = bar; b.x = xb_xcc_id(); b.st = st;
    if (threadIdx.x == 0) (void)xb_add(&bar[XB_XCNT(b.x)], 1u);
    return b;
}
__device__ __forceinline__ void xcd_barrier_complete(unsigned* bar, unsigned x, unsigned& nloc, unsigned& nx) {
    const unsigned G = gridDim.x * gridDim.y * gridDim.z;
    unsigned sum, cnt, mine, sp = 0u;
    for (;;) {
        sum = 0u; cnt = 0u; mine = 0u;
#pragma unroll
        for (unsigned j = 0; j < 16; ++j) { const unsigned c = xb_ld(&bar[XB_XCNT(j)]); sum += c; cnt += (c > 0u) ? 1u : 0u; mine = (j == x) ? c : mine; }
        if (sum == G) break;
        __builtin_amdgcn_s_sleep(1);
        if ((++sp & 255u) == 0u) { if (xb_ld(&bar[XB_TMO])) break; if (sp > XB_SPIN_CAP) { atomicAdd(&bar[XB_TMO], 1u); break; } }
    }
    nloc = mine > 0u ? mine : 1u; nx = cnt > 0u ? cnt : 1u;
}

__device__ __forceinline__ void xcd_barrier(const XcdBarrier& b) {
    asm volatile("s_waitcnt vmcnt(0)" ::: "memory");
    __syncthreads();
    if (threadIdx.x == 0) {
        unsigned* bar = b.bar;
        __builtin_amdgcn_s_waitcnt(0);
        unsigned nloc = b.st[0], nx = b.st[1];
        if (nloc == 0u) { xcd_barrier_complete(bar, b.x, nloc, nx); b.st[0] = nloc; b.st[1] = nx; }
        const unsigned old = xb_add(&bar[XB_XSUB(b.x)], 1u);
        const unsigned gen = old / nloc;
        if (old + 1u == (gen + 1u) * nloc) {
            __builtin_amdgcn_fence(__ATOMIC_RELEASE, "agent");
            asm volatile("s_waitcnt vmcnt(0)" ::: "memory");
            const unsigned og = xb_add(&bar[XB_TOP], 1u);
            const unsigned tg = og / nx;
            if (og + 1u == (tg + 1u) * nx) xb_add(&bar[XB_TOPGEN], 1u);
            else XB_SPIN(xb_ld(&bar[XB_TOPGEN]) == tg, bar);
            __builtin_amdgcn_fence(__ATOMIC_ACQUIRE, "agent");
            xb_add(&bar[XB_XGEN(b.x)], 1u);
            asm volatile("s_waitcnt vmcnt(0)" ::: "memory");
        } else {
            XB_SPIN(xb_ld(&bar[XB_XGEN(b.x)]) == gen, bar);
            __builtin_amdgcn_fence(__ATOMIC_ACQUIRE, "agent");
            asm volatile("s_waitcnt vmcnt(0)" ::: "memory");
        }
    }
    __syncthreads();
}

enum { PT_PRO = 0, PT_QKV, PT_ATTN, PT_MERGE, PT_AOUT, PT_UP, PT_DOWN, PT_MIN, PT_P1, PT_SCAN, PT_P2, PT_MOUT };
DI void decode_phase(int ph, int& type, int& layer, int& half) {
    half = 0;
    if (ph == 0) { type = PT_PRO; layer = 0; return; }
    int p = ph - 1; layer = 0;
    for (;;) { const int len = (layer & 1) ? 7 : 10; if (p < len) break; p -= len; ++layer; }
    if (layer & 1) { type = (p == 0) ? PT_MIN : (p == 1) ? PT_P1 : (p == 2) ? PT_SCAN : (p == 3) ? PT_P2 : (p == 4) ? PT_MOUT : (p == 5) ? PT_UP : PT_DOWN; }
    else { if (p < 8) { half = p >> 2; const int q = p & 3; type = (q == 0) ? PT_QKV : (q == 1) ? PT_ATTN : (q == 2) ? PT_MERGE : PT_AOUT; } else type = (p == 8) ? PT_UP : PT_DOWN; }
}

__global__ void __launch_bounds__(512, 2) mega(Args a) {
    extern __shared__ __attribute__((aligned(16))) unsigned char lds_raw[];
    LAS unsigned char* lds = (LAS unsigned char*)lds_raw;
    const int G = gridDim.x, bid = blockIdx.x;
    unsigned char* ws = a.ws;
    ss_t* ssb = (ss_t*)(ws + WS_SS);
    bf16_t* XB = (bf16_t*)(ws + WS_XB);
    unsigned char* R = ws + WS_R;
    volatile LAS unsigned* MISC = (volatile LAS unsigned*)(lds + 147200);
    if (threadIdx.x < 2) MISC[threadIdx.x] = 0u;
    __syncthreads();
    XcdBarrier bar = xcd_barrier_post((unsigned*)ws, MISC);
#pragma unroll 1
    for (int ph = a.ph_lo; ph < a.ph_hi; ++ph) {
        if (ph > a.ph_lo) { if (a.ph_hi > 1000) cg::this_grid().sync();   else xcd_barrier(bar); }
        int type, L, half; decode_phase(ph, type, L, half);
        const int j = L >> 1;
        if (type == PT_PRO) { prologue(a, lds, G, bid); }
        else if (type == PT_QKV || type == PT_MIN || type == PT_UP) {
            pg8::Gemm g; pg8::EpiScale E;
            if (type == PT_QKV) { g = pg8::Gemm{XB + (size_t)half * TH * 1024, (const bf16_t*)(ws + W_AIN + (size_t)j * 18 * MiB), TH, 9216, 1024}; E = pg8::EpiScale{(bf16_t*)R, 1024, ssb + (size_t)(2 * L) * T_ALL + half * TH, 0, a.in[5] + j * 192, a.in[6] + j * 192}; }
            else if (type == PT_MIN) { g = pg8::Gemm{XB, (const bf16_t*)(ws + W_MIN + (size_t)j * 6 * MiB), T_ALL, 3072, 1024}; E = pg8::EpiScale{(bf16_t*)R, 3072, ssb + (size_t)(2 * L) * T_ALL, 1, nullptr, nullptr}; }
            else { g = pg8::Gemm{XB, (const bf16_t*)(ws + W_UP + (size_t)L * 8 * MiB), T_ALL, 4096, 1024}; E = pg8::EpiScale{(bf16_t*)R, 4096, ssb + (size_t)(2 * L + 1) * T_ALL, 2, nullptr, nullptr}; }
            pg8::StaticOrder S; S.init(g.M, g.N, G, bid);
            pg8::gemm_phase<pg8::EpiScale, pg8::StaticOrder, true, true>(lds, g, S, E);
            if (type == PT_MIN) gates_phase(lds, XB, ssb + (size_t)(2 * L) * T_ALL, a.in[8] + (size_t)j * 1024 * 3080, a.in[1] + (size_t)L * 1024, a.in[9] + j * 8, (float*)(R + R_GATES), G, bid);
        }
        else if (type == PT_AOUT || type == PT_MOUT || type == PT_DOWN) {
            pg8::Gemm g; pg8::EpiRes E;
            if (type == PT_AOUT) { g = pg8::Gemm{(const bf16_t*)R, (const bf16_t*)(ws + W_AOUT + (size_t)j * 2 * MiB), TH, 1024, 1024}; E = pg8::EpiRes{nullptr, XB, ssb + (size_t)(2 * L + 1) * T_ALL, half * TH}; }
            else if (type == PT_MOUT) { g = pg8::Gemm{(const bf16_t*)(R + R_YM), (const bf16_t*)(ws + W_MOUT + (size_t)j * 2 * MiB), T_ALL, 1024, 1024}; E = pg8::EpiRes{nullptr, XB, ssb + (size_t)(2 * L + 1) * T_ALL, 0}; }
            else { g = pg8::Gemm{(const bf16_t*)R, (const bf16_t*)(ws + W_DN + (size_t)L * 8 * MiB), T_ALL, 1024, 4096}; E = pg8::EpiRes{(L == 3) ? a.out : nullptr, XB, (L < 3) ? ssb + (size_t)(2 * L + 2) * T_ALL : nullptr, 0}; }
            pg8::StaticOrder S; S.init(g.M, g.N, G, bid);
            pg8::gemm_phase<pg8::EpiRes, pg8::StaticOrder, true, true>(lds, g, S, E);
        }
        else if (type == PT_ATTN) { attn_phase(lds, (bf16_t*)R, (float*)(R + R_LSE), a.in[5] + j * 192, a.in[6] + j * 192, a.in[3], G, bid); }
        else if (type == PT_MERGE) { merge_phase((bf16_t*)R, (const float*)(R + R_LSE), G, bid); }
        else if (type == PT_P1) { ml_pass<false>(lds, (const bf16_t*)R, (const float*)(R + R_GATES), (float*)(R + R_STATE), (float*)(R + R_SC), (bf16_t*)(R + R_YM), a.in[10] + (size_t)j * 4096, a.in[11] + (size_t)j * 1024, a.in[12] + (size_t)j * 1024, G, bid); }
        else if (type == PT_SCAN) { scan_phase((float*)(R + R_STATE), (const float*)(R + R_SC), G, bid); }
        else if (type == PT_P2) { ml_pass<true>(lds, (const bf16_t*)R, (const float*)(R + R_GATES), (float*)(R + R_STATE), (float*)(R + R_SC), (bf16_t*)(R + R_YM), a.in[10] + (size_t)j * 4096, a.in[11] + (size_t)j * 1024, a.in[12] + (size_t)j * 1024, G, bid); }
    }
}

#ifndef MK_ONE_LAUNCH
#define MK_ONE_LAUNCH 1
#endif
extern "C" void kernel_launch(void* const* d_in, const int* in_sizes, int n_in, void* d_out, int out_size, void* d_ws, size_t ws_size, hipStream_t stream) {
    static int grid = 0;
    if (grid == 0) {
        if (n_in != 16 || out_size != T_ALL * DM || ws_size < WS_NEED) { fprintf(stderr, "kernel_launch: unexpected shapes / workspace %zu\n", ws_size); grid = -1; return; }
        int dev = 0, cus = 0, per_cu = 0;
        hipGetDevice(&dev); hipDeviceGetAttribute(&cus, hipDeviceAttributeMultiprocessorCount, dev);
        hipFuncSetAttribute((const void*)mega, hipFuncAttributeMaxDynamicSharedMemorySize, LDS_BYTES);
        hipOccupancyMaxActiveBlocksPerMultiprocessor(&per_cu, (const void*)mega, 512, LDS_BYTES);
        (void)hipGetLastError();
        if (per_cu < 1) per_cu = 1;
        grid = cus * 1;
        if (grid <= 0) grid = 256;
    }
    if (grid < 0) return;
    Args a{};
    for (int i = 0; i < 16; ++i) a.in[i] = (const float*)d_in[i];
    a.out = (float*)d_out; a.ws = (unsigned char*)d_ws;
#if MK_ONE_LAUNCH
    (void)hipMemsetAsync(d_ws, 0, 16384, stream);
    a.ph_lo = 0; a.ph_hi = NPH;
    void* args[] = {&a};
    hipError_t e = hipLaunchCooperativeKernel((const void*)mega, dim3(grid), dim3(512), args, LDS_BYTES, stream);
    if (e != hipSuccess) fprintf(stderr, "cooperative launch failed: %s\n", hipGetErrorString(e));
#else
    for (int ph = 0; ph < DBG_NPH; ++ph) { a.ph_lo = ph; a.ph_hi = ph + 1; hipLaunchKernelGGL(mega, dim3(grid), dim3(512), LDS_BYTES, stream, a); }
#endif
}
```
